# Optimizing an MI355X kernel written in HIP

```python
import jax, jax.numpy as jnp
from jax import lax
import numpy as np

D_MODEL = 1024
BATCH = 4
SEQ = 4096
DEPTH = 4

CTX_LEN = 256
GRID_W = 64
HEAD_DIM = 64
N_HEADS_A = 8
N_KV_A = 2
N_HEADS_B = 8
N_KV_B = 2
WINDOW = 128
BLOCK = 128
D_FF = -(-8 * D_MODEL // (3 * 256)) * 256
ROPE_THETA = 10000.0
NORM_EPS = 1e-6
NEG_INF = -1e30
Q_A = N_HEADS_A * HEAD_DIM
KV_A = N_KV_A * HEAD_DIM
Q_B = N_HEADS_B * HEAD_DIM
KV_B = N_KV_B * HEAD_DIM
IN_SIZES = (Q_A, KV_A, KV_A, Q_B, KV_B, KV_B, D_MODEL, D_MODEL)
IN_COLS = Q_A + 2 * KV_A + Q_B + 2 * KV_B + 2 * D_MODEL

kernel_name = "hybrid_dit_window_dense_gqa_prefix"


def rms_norm(x, g):
    xf = x.astype(jnp.float32)
    y = xf * lax.rsqrt(jnp.mean(xf * xf, axis=-1, keepdims=True) + NORM_EPS)
    return (y * g.astype(jnp.float32)).astype(x.dtype)


def modulate(h, shift, scale):
    return h * (1 + scale) + shift


def axial_rope_tables(n_tokens):
    rows = n_tokens // GRID_W
    row = jnp.repeat(jnp.arange(rows, dtype=jnp.float32), GRID_W)
    col = jnp.tile(jnp.arange(GRID_W, dtype=jnp.float32), rows)
    axis_dims = HEAD_DIM // 2
    inv = ROPE_THETA ** (-jnp.arange(0, axis_dims, 2, dtype=jnp.float32) / axis_dims)
    ang = jnp.stack([row[:, None] * inv, col[:, None] * inv], axis=1)
    return jnp.cos(ang), jnp.sin(ang)


def apply_rope(x, cos, sin):
    xr = x.astype(jnp.float32).reshape(x.shape[:-1] + (2, 2, HEAD_DIM // 4))
    x1, x2 = xr[..., 0, :], xr[..., 1, :]
    cs, sn = cos[:, None], sin[:, None]
    out = jnp.stack([x1 * cs - x2 * sn, x2 * cs + x1 * sn], axis=-2)
    return out.reshape(x.shape).astype(x.dtype)


def split_in_proj(z):
    pts = np.cumsum(IN_SIZES)[:-1].tolist()
    qa, ka, va, qb, kb, vb, ga, gb = jnp.split(z, pts, axis=-1)
    lead = z.shape[:-1]
    heads = lambda t, n: t.reshape(lead + (n, HEAD_DIM))
    return (heads(qa, N_HEADS_A), heads(ka, N_KV_A), heads(va, N_KV_A),
            heads(qb, N_HEADS_B), heads(kb, N_KV_B), heads(vb, N_KV_B), ga, gb)


def softmax_with_sink(s, sink_hg):
    sk = jnp.broadcast_to(sink_hg.astype(jnp.float32)[:, :, None, None], s.shape[:-1] + (1,))
    p = jax.nn.softmax(jnp.concatenate([s, sk], axis=-1), axis=-1)
    return p[..., :-1]


def window_attention_latent(q, k, v, kc, vc, sink):
    B, S = q.shape[:2]
    C = kc.shape[1]
    nb = S // BLOCK
    G = N_HEADS_A // N_KV_A
    scale = HEAD_DIM ** -0.5
    qb = q.reshape(B, nb, BLOCK, N_KV_A, G, HEAD_DIM)
    pad = ((0, 0), (BLOCK, BLOCK), (0, 0), (0, 0))
    kp = jnp.pad(k, pad).reshape(B, nb + 2, BLOCK, N_KV_A, HEAD_DIM)
    vp = jnp.pad(v, pad).reshape(B, nb + 2, BLOCK, N_KV_A, HEAD_DIM)
    kw = jnp.concatenate([kp[:, :-2], kp[:, 1:-1], kp[:, 2:]], axis=2)
    vw = jnp.concatenate([vp[:, :-2], vp[:, 1:-1], vp[:, 2:]], axis=2)
    s_win = jnp.einsum('bnqhgd,bnkhd->bnhgqk', qb, kw).astype(jnp.float32) * scale
    qpos = jnp.arange(nb)[:, None] * BLOCK + jnp.arange(BLOCK)[None, :]
    kpos = jnp.arange(nb)[:, None] * BLOCK - BLOCK + jnp.arange(3 * BLOCK)[None, :]
    rel = kpos[:, None, :] - qpos[:, :, None]
    valid = (jnp.abs(rel) <= WINDOW) & (kpos[:, None, :] >= 0) & (kpos[:, None, :] < S)
    s_win = jnp.where(valid[None, :, None, None], s_win, NEG_INF)
    s_ctx = jnp.einsum('bnqhgd,bchd->bnhgqc', qb, kc).astype(jnp.float32) * scale
    p = softmax_with_sink(jnp.concatenate([s_win, s_ctx], axis=-1), sink.reshape(N_KV_A, G)).astype(v.dtype)
    out = (jnp.einsum('bnhgqk,bnkhd->bnqhgd', p[..., :3 * BLOCK], vw)
           + jnp.einsum('bnhgqc,bchd->bnqhgd', p[..., 3 * BLOCK:], vc))
    return out.reshape(B, S, Q_A)


def full_attention_latent(q, k, v, kc, vc):
    B, S = q.shape[:2]
    nb = S // BLOCK
    G = N_HEADS_B // N_KV_B
    scale = HEAD_DIM ** -0.5
    kall = jnp.concatenate([k, kc], axis=1)
    vall = jnp.concatenate([v, vc], axis=1)
    qb = q.reshape(B, nb, BLOCK, N_KV_B, G, HEAD_DIM).transpose(1, 0, 2, 3, 4, 5)

    def one_block(qblk):
        s = jnp.einsum('bqhgd,bkhd->bhgqk', qblk, kall).astype(jnp.float32) * scale
        p = jax.nn.softmax(s, axis=-1).astype(vall.dtype)
        return jnp.einsum('bhgqk,bkhd->bqhgd', p, vall)

    out = lax.map(one_block, qb)
    return out.transpose(1, 0, 2, 3, 4, 5).reshape(B, S, Q_B)


def context_attention(q, k, v, n_kv, sink):
    B, C, H, _ = q.shape
    G = H // n_kv
    qg = q.reshape(B, C, n_kv, G, HEAD_DIM)
    s = jnp.einsum('bqhgd,bkhd->bhgqk', qg, k).astype(jnp.float32) * (HEAD_DIM ** -0.5)
    if sink is None:
        p = jax.nn.softmax(s, axis=-1)
    else:
        p = softmax_with_sink(s, sink.reshape(n_kv, G))
    out = jnp.einsum('bhgqk,bkhd->bqhgd', p.astype(v.dtype), v)
    return out.reshape(B, C, H * HEAD_DIM)


def merge_branches(ya, yb, ga, gb, w_pa, w_pb, w_o):
    m = jax.nn.sigmoid(ga) * (ya @ w_pa) + jax.nn.sigmoid(gb) * (yb @ w_pb)
    return m @ w_o


def swiglu(h, w_gate, w_up, w_down):
    return (jax.nn.silu(h @ w_gate) * (h @ w_up)) @ w_down


def setup_inputs(seed: int = 0) -> dict:
    key = jax.random.key(seed)
    ks = jax.random.split(key, 20)
    f32 = jnp.float32
    nrm = lambda k, shape, s: jax.random.normal(k, shape, f32) * s
    return {
        "x": nrm(ks[0], (BATCH, SEQ, D_MODEL), 1.0),
        "c": nrm(ks[1], (BATCH, D_MODEL), 1.0),
        "ctx": nrm(ks[2], (BATCH, CTX_LEN, D_MODEL), 1.0),
        "c_ctx": nrm(ks[3], (D_MODEL,), 1.0),
        "w_ada": nrm(ks[4], (DEPTH, D_MODEL, 6 * D_MODEL), 0.5 * D_MODEL ** -0.5),
        "b_ada": nrm(ks[5], (DEPTH, 6 * D_MODEL), 0.01),
        "norm1_g": 1.0 + nrm(ks[6], (DEPTH, D_MODEL), 0.02),
        "norm2_g": 1.0 + nrm(ks[7], (DEPTH, D_MODEL), 0.02),
        "w_in": nrm(ks[8], (DEPTH, D_MODEL, IN_COLS), D_MODEL ** -0.5),
        "q_norm_g": 1.0 + nrm(ks[9], (DEPTH, HEAD_DIM), 0.02),
        "k_norm_g": 1.0 + nrm(ks[10], (DEPTH, HEAD_DIM), 0.02),
        "sink_a": nrm(ks[11], (DEPTH, N_HEADS_A), 0.5),
        "w_proj_a": nrm(ks[12], (DEPTH, Q_A, D_MODEL), Q_A ** -0.5),
        "w_proj_b": nrm(ks[13], (DEPTH, Q_B, D_MODEL), Q_B ** -0.5),
        "w_out": nrm(ks[14], (DEPTH, D_MODEL, D_MODEL), D_MODEL ** -0.5),
        "w_ffn_gate": nrm(ks[15], (DEPTH, D_MODEL, D_FF), D_MODEL ** -0.5),
        "w_ffn_up": nrm(ks[16], (DEPTH, D_MODEL, D_FF), D_MODEL ** -0.5),
        "w_ffn_down": nrm(ks[17], (DEPTH, D_FF, D_MODEL), D_FF ** -0.5),
        "final_norm_g": 1.0 + nrm(ks[18], (D_MODEL,), 0.02),
    }


def reference(x, c, ctx, c_ctx, w_ada, b_ada, norm1_g, norm2_g, w_in, q_norm_g, k_norm_g, sink_a,
              w_proj_a, w_proj_b, w_out, w_ffn_gate, w_ffn_up, w_ffn_down, final_norm_g):
    cos, sin = axial_rope_tables(x.shape[1])
    silu_c = jax.nn.silu(c)
    silu_cc = jax.nn.silu(c_ctx)
    xc = ctx
    for l in range(DEPTH):
        last = l == DEPTH - 1
        mod = silu_c @ w_ada[l] + b_ada[l]
        mod_c = silu_cc @ w_ada[l] + b_ada[l]
        sh1, sc1, gt1, sh2, sc2, gt2 = jnp.split(mod[:, None, :], 6, axis=-1)
        csh1, csc1, cgt1, csh2, csc2, cgt2 = jnp.split(mod_c, 6, axis=-1)

        h = modulate(rms_norm(x, norm1_g[l]), sh1, sc1)
        hc = modulate(rms_norm(xc, norm1_g[l]), csh1, csc1)
        qa, ka, va, qb, kb, vb, ga, gb = split_in_proj(h @ w_in[l])
        qac, kac, vac, qbc, kbc, vbc, gac, gbc = split_in_proj(hc @ w_in[l])
        qb = rms_norm(qb, q_norm_g[l])
        kb = rms_norm(kb, k_norm_g[l])
        kbc = rms_norm(kbc, k_norm_g[l])
        ya = window_attention_latent(apply_rope(qa, cos, sin), apply_rope(ka, cos, sin), va, kac, vac, sink_a[l])
        yb = full_attention_latent(apply_rope(qb, cos, sin), apply_rope(kb, cos, sin), vb, kbc, vbc)
        x = x + gt1 * merge_branches(ya, yb, ga, gb, w_proj_a[l], w_proj_b[l], w_out[l])

        h2 = modulate(rms_norm(x, norm2_g[l]), sh2, sc2)
        x = x + gt2 * swiglu(h2, w_ffn_gate[l], w_ffn_up[l], w_ffn_down[l])

        if not last:
            qbc = rms_norm(qbc, q_norm_g[l])
            yac = context_attention(qac, kac, vac, N_KV_A, sink_a[l])
            ybc = context_attention(qbc, kbc, vbc, N_KV_B, None)
            xc = xc + cgt1 * merge_branches(yac, ybc, gac, gbc, w_proj_a[l], w_proj_b[l], w_out[l])
            h2c = modulate(rms_norm(xc, norm2_g[l]), csh2, csc2)
            xc = xc + cgt2 * swiglu(h2c, w_ffn_gate[l], w_ffn_up[l], w_ffn_down[l])
    return rms_norm(x, final_norm_g)
```

```cpp
#include <hip/hip_runtime.h>
#include <hip/hip_cooperative_groups.h>
#include <cstdio>
#include <cstdint>
namespace cg = cooperative_groups;

constexpr int DM = 1024, NB = 4, SEQ = 4096, DEPTH = 4, CTXL = 256, SALL = SEQ + CTXL, MLAT = NB * SEQ, MCTX = NB * CTXL, MALL = MLAT + MCTX;
constexpr int INC = 3584, DFF = 2816, NGU = 2 * DFF, NPAN_ALL = MALL / 256;
constexpr float NORM_EPS = 1e-6f;
constexpr float QSCALE = 0.125f * 1.4426950408889634f;
constexpr float LOG2E = 1.4426950408889634f;
namespace pg8 {
#define PG8_LAS __attribute__((address_space(3)))
typedef unsigned short bf16_t;
typedef short bf16x8 __attribute__((ext_vector_type(8)));
typedef float f32x4 __attribute__((ext_vector_type(4)));
typedef unsigned u32x4 __attribute__((ext_vector_type(4)));
constexpr int BM = 256, BK = 64, HALF = 128, HTB = HALF * BK * 2  , STAGE_BYTES = 8 * HTB, NXCD = 8, WGM = 8;

__host__ __device__ __forceinline__ int lds_byte(int r, int c) { const int st = (r >> 4) * 2 + (c >> 5), rr = r & 15, cc = c & 31, ob = rr * 64 + cc * 2; return st * 1024 + (ob ^ (((ob >> 9) & 1) << 5)); }
__host__ __device__ __forceinline__ void stage_rc(int b, int& R, int& C) { const int st = b / 1024, sb = b % 1024, swz = sb ^ (((sb >> 9) & 1) << 5); R = (st >> 1) * 16 + swz / 64; C = (st & 1) * 32 + (swz % 64) / 2; }
__host__ __device__ __forceinline__ int perm32(int rho) { const int n = rho >> 4, i = rho & 15; return 8 * (i >> 2) + 4 * n + (i & 3); }

struct Unit { int pm, pn; };
struct Gemm { const bf16_t* A; const bf16_t* Bt; int M, N, K; };

struct StaticOrder {
    int nM, nN, nwg, G, c;
    __host__ __device__ void init(int M, int N, int G_, int c_) { nM = M / BM; nN = N / BM; nwg = nM * nN; G = G_; c = c_; }
    __host__ __device__ bool next(int i, Unit& u) const {
        const long L = (long)i * G + c; if (L >= nwg) return false;
        int wgid = (int)L; { const int q = nwg / NXCD, r = nwg % NXCD, xcd = wgid % NXCD, off = wgid / NXCD; wgid = (xcd < r ? xcd * (q + 1) : r * (q + 1) + (xcd - r) * q) + off; }
        const int nig = WGM * nN, gid = wgid / nig, fm = gid * WGM, gsz = (nM - fm) < WGM ? (nM - fm) : WGM;
        u.pm = fm + ((wgid % nig) % gsz); u.pn = (wgid % nig) / gsz; return true;
    }
    __device__ __forceinline__ void a_ready(const Unit&) const {}
    __device__ __forceinline__ void done(const Unit&) const {}
};

__device__ __forceinline__ unsigned cvt_pk_bf16(float lo, float hi) { unsigned r; asm volatile("v_cvt_pk_bf16_f32 %0, %1, %2" : "=v"(r) : "v"(lo), "v"(hi)); return r; }
typedef float f32x2 __attribute__((ext_vector_type(2)));
typedef unsigned u32x2 __attribute__((ext_vector_type(2)));
__device__ __forceinline__ u32x2 pack4(f32x4 v) { u32x2 w; w.x = cvt_pk_bf16(v[0], v[1]); w.y = cvt_pk_bf16(v[2], v[3]); return w; }
__device__ __forceinline__ f32x4 unpack4(u32x2 w) { f32x4 v; v[0] = __uint_as_float(w.x << 16); v[1] = __uint_as_float(w.x & 0xffff0000u); v[2] = __uint_as_float(w.y << 16); v[3] = __uint_as_float(w.y & 0xffff0000u); return v; }
__device__ __forceinline__ float sigmoidf_(float v) { return 1.0f / (1.0f + __expf(-v)); }

struct EpiInProj {
    static constexpr bool PERM = false, AFTER_DRAIN = false;
    static __device__ __forceinline__ bool keep(const Unit&) { return false; }
    bf16_t *Q, *K, *VT, *SG; const float *qg, *kg; const PG8_LAS float* ropel; const float* rowss; const float* bias;
    __device__ __forceinline__ void operator()(f32x4 (&acc)[2][2][4][2], const Unit& u, int wr, int wc, int fr, int fq) const {
        const int pn = u.pn; const int vb = u.pm < (MLAT / 256) ? (u.pm >> 4) : 4;
        const int row0 = u.pm * 256 + wr * 64 + fr;
        float rstd[2][4]; f32x4 bv[2][2];
#pragma unroll
        for (int ai = 0; ai < 2; ++ai)
#pragma unroll
            for (int m = 0; m < 4; ++m) rstd[ai][m] = rowss ? rowss[row0 + ai * 128 + m * 16] : 0.f;
#pragma unroll
        for (int bj = 0; bj < 2; ++bj)
#pragma unroll
            for (int n = 0; n < 2; ++n) bv[bj][n] = rowss ? *(const f32x4*)(bias + vb * INC + pn * 256 + 128 * bj + 32 * wc + 16 * n + 4 * fq) : (f32x4){0.f, 0.f, 0.f, 0.f};
        const int br = (pn >= 6) ? ((pn - 6) >> 2) : (pn >= 3 ? 1 : 0), pl = pn - 3 * br;
        const bool isQ = pl < 2, isV = (!isQ) && wc >= 2, donorm = (pn < 6) && (br == 1) && !isV;
        const float* gvec = isQ ? qg : kg;
        f32x4 gl[2][2];
#pragma unroll
        for (int bj = 0; bj < 2; ++bj)
#pragma unroll
            for (int n = 0; n < 2; ++n) gl[bj][n] = donorm ? *(const f32x4*)(gvec + 32 * bj + 16 * n + 4 * fq) : (f32x4){1.f, 1.f, 1.f, 1.f};
#pragma unroll
        for (int ai = 0; ai < 2; ++ai)
#pragma unroll
            for (int m = 0; m < 4; ++m) rstd[ai][m] = rowss ? 1.0f / sqrtf(rstd[ai][m] * (1.0f / 1024.0f) + NORM_EPS) : 1.0f;
        if (pn >= 6) {
            const int cbase = ((pn - 6) & 3) * 256 + wc * 64 + 4 * fq;
#pragma unroll
            for (int ai = 0; ai < 2; ++ai)
#pragma unroll
                for (int m = 0; m < 4; ++m) { const int row = row0 + ai * 128 + m * 16; bf16_t* dst = SG + ((size_t)br * MALL + row) * 1024 + cbase;
#pragma unroll
                    for (int bj = 0; bj < 2; ++bj)
#pragma unroll
                        for (int n = 0; n < 2; ++n) { f32x4 v = acc[ai][bj][m][n] * rstd[ai][m] + bv[bj][n];
                            v[0] = sigmoidf_(v[0]); v[1] = sigmoidf_(v[1]); v[2] = sigmoidf_(v[2]); v[3] = sigmoidf_(v[3]);
                            *(u32x2*)(dst + 32 * bj + 16 * n) = pack4(v); } }
            return;
        }
        const int head = isQ ? pl * 4 + wc : (wc & 1);
#pragma unroll
        for (int ai = 0; ai < 2; ++ai)
#pragma unroll
            for (int m = 0; m < 4; ++m) {
                const int row = row0 + ai * 128 + m * 16;
                const bool isctx = row >= MLAT;
                const int b = isctx ? (row - MLAT) >> 8 : row >> 12;
                const int sall = isctx ? SEQ + ((row - MLAT) & 255) : row & (SEQ - 1);
                f32x4 v[2][2];
#pragma unroll
                for (int bj = 0; bj < 2; ++bj)
#pragma unroll
                    for (int n = 0; n < 2; ++n) v[bj][n] = acc[ai][bj][m][n] * rstd[ai][m] + bv[bj][n];
                if (donorm) {
                    float ss = 0.f;
#pragma unroll
                    for (int bj = 0; bj < 2; ++bj)
#pragma unroll
                        for (int n = 0; n < 2; ++n) ss += (v[bj][n][0] * v[bj][n][0] + v[bj][n][1] * v[bj][n][1]) + (v[bj][n][2] * v[bj][n][2] + v[bj][n][3] * v[bj][n][3]);
                    ss += __shfl_xor(ss, 16); ss += __shfl_xor(ss, 32);
                    const float rs_ = 1.0f / sqrtf(ss * (1.0f / 64.0f) + NORM_EPS);
#pragma unroll
                    for (int bj = 0; bj < 2; ++bj)
#pragma unroll
                        for (int n = 0; n < 2; ++n) v[bj][n] = (v[bj][n] * rs_) * gl[bj][n];
                }
                if (!isV && !isctx) {
#pragma unroll
                    for (int bj = 0; bj < 2; ++bj) { const int pos = bj ? (sall & 63) : (sall >> 6);
                        const f32x4 c = *(const PG8_LAS f32x4*)(ropel + pos * 16 + 4 * fq), s = *(const PG8_LAS f32x4*)(ropel + 1024 + pos * 16 + 4 * fq);
                        const f32x4 x1 = v[bj][0], x2 = v[bj][1]; v[bj][0] = x1 * c - x2 * s; v[bj][1] = x2 * c + x1 * s; }
                }
                if (isQ) { bf16_t* dst = Q + ((size_t)((br * NB + b) * 8 + head) * SALL + sall) * 64 + 4 * fq;
#pragma unroll
                    for (int bj = 0; bj < 2; ++bj)
#pragma unroll
                        for (int n = 0; n < 2; ++n) *(u32x2*)(dst + 32 * bj + 16 * n) = pack4(v[bj][n] * QSCALE);
                } else if (!isV) { bf16_t* dst = K + ((size_t)((br * NB + b) * 2 + head) * SALL + sall) * 64 + 4 * fq;
#pragma unroll
                    for (int bj = 0; bj < 2; ++bj)
#pragma unroll
                        for (int n = 0; n < 2; ++n) *(u32x2*)(dst + 32 * bj + 16 * n) = pack4(v[bj][n]);
                } else { bf16_t* dst = VT + ((size_t)((br * NB + b) * 2 + head) * 64 + 4 * fq) * SALL + sall;
#pragma unroll
                    for (int bj = 0; bj < 2; ++bj)
#pragma unroll
                        for (int n = 0; n < 2; ++n) { const u32x2 w = pack4(v[bj][n]); bf16_t* d2 = dst + (size_t)(32 * bj + 16 * n) * SALL;
                            d2[0] = (bf16_t)(w.x & 0xffffu); d2[SALL] = (bf16_t)(w.x >> 16); d2[2 * SALL] = (bf16_t)(w.y & 0xffffu); d2[3 * SALL] = (bf16_t)(w.y >> 16); }
                }
            }
    }
};
struct EpiMerge {
    static constexpr bool PERM = false, AFTER_DRAIN = false;
    static __device__ __forceinline__ bool keep(const Unit& u) { return u.pn < 4; }
    const bf16_t* SG; bf16_t* Mb;
    __device__ __forceinline__ void operator()(f32x4 (&acc)[2][2][4][2], const Unit& u, int wr, int wc, int fr, int fq) const {
        const bool second = u.pn >= 4; const int pn = u.pn & 3, pm = second ? u.pm - NPAN_ALL : u.pm;
        const size_t row0 = (size_t)(pm * 256 + wr * 64 + fr);
#pragma unroll
        for (int bj = 0; bj < 2; ++bj)
#pragma unroll
          for (int n = 0; n < 2; ++n) {
            const int col = pn * 256 + 128 * bj + 32 * wc + 16 * n + 4 * fq;
            u32x2 sbw[2][4], saw[2][4];
#pragma unroll
            for (int ai = 0; ai < 2; ++ai)
#pragma unroll
                for (int m = 0; m < 4; ++m) { const size_t off = (row0 + ai * 128 + m * 16) * 1024 + col;
                    sbw[ai][m] = *(const u32x2*)(SG + (size_t)MALL * 1024 + off); saw[ai][m] = second ? sbw[ai][m] : *(const u32x2*)(SG + off); }
#pragma unroll
            for (int ai = 0; ai < 2; ++ai)
#pragma unroll
                for (int m = 0; m < 4; ++m) { const size_t off = (row0 + ai * 128 + m * 16) * 1024 + col;
                    const f32x4 sb = unpack4(sbw[ai][m]);
                    if (!second) { const f32x4 sa = unpack4(saw[ai][m]); acc[ai][bj][m][n] = acc[ai][bj][m][n] * (sa / sb); }
                    else *(u32x2*)(Mb + off) = pack4(acc[ai][bj][m][n] * sb); }
          }
    }
};
struct EpiResid {
    static constexpr bool PERM = false, AFTER_DRAIN = false;
    static __device__ __forceinline__ bool keep(const Unit&) { return false; }
    const float* gate; float* X;
    bf16_t* XG; float* rowss; const float* ng; const float* nsc;
    __device__ __forceinline__ void operator()(f32x4 (&acc)[2][2][4][2], const Unit& u, int wr, int wc, int fr, int fq) const {
        const int v = u.pm < (MLAT / 256) ? (u.pm >> 4) : 4;
        const size_t row0 = (size_t)(u.pm * 256 + wr * 64 + fr);
        float ssq[2][4];
#pragma unroll
        for (int ai = 0; ai < 2; ++ai)
#pragma unroll
            for (int m = 0; m < 4; ++m) ssq[ai][m] = 0.f;
#pragma unroll
        for (int bj = 0; bj < 2; ++bj)
#pragma unroll
          for (int n = 0; n < 2; ++n) {
            const int col = u.pn * 256 + 128 * bj + 32 * wc + 16 * n + 4 * fq;
            const f32x4 g = *(const f32x4*)(gate + v * 6144 + col);
            f32x4 G = {0.f, 0.f, 0.f, 0.f};
            if (XG) G = *(const f32x4*)(ng + col) * (*(const f32x4*)(nsc + v * 6144 + col) + 1.0f);
            f32x4 xv[2][4];
#pragma unroll
            for (int ai = 0; ai < 2; ++ai)
#pragma unroll
                for (int m = 0; m < 4; ++m) xv[ai][m] = *(const f32x4*)(X + (row0 + ai * 128 + m * 16) * 1024 + col);
#pragma unroll
            for (int ai = 0; ai < 2; ++ai)
#pragma unroll
                for (int m = 0; m < 4; ++m) { const size_t off = (row0 + ai * 128 + m * 16) * 1024 + col;
                    const f32x4 xn = xv[ai][m] + g * acc[ai][bj][m][n]; *(f32x4*)(X + off) = xn;
                    if (XG) { ssq[ai][m] += (xn[0] * xn[0] + xn[1] * xn[1]) + (xn[2] * xn[2] + xn[3] * xn[3]); *(u32x2*)(XG + off) = pack4(xn * G); } }
          }
        if (XG) {
#pragma unroll
            for (int ai = 0; ai < 2; ++ai)
#pragma unroll
                for (int m = 0; m < 4; ++m) { float q = ssq[ai][m]; q += __shfl_xor(q, 16); q += __shfl_xor(q, 32);
                    if (fq == 0) atomicAdd(rowss + row0 + ai * 128 + m * 16, q); }
        }
    }
};
struct EpiSwiGLU {
    static constexpr bool PERM = false, AFTER_DRAIN = false;
    static __device__ __forceinline__ bool keep(const Unit&) { return false; }
    bf16_t* Hf;
    __device__ __forceinline__ void operator()(f32x4 (&acc)[2][2][4][2], const Unit& u, int wr, int wc, int fr, int fq) const {
#pragma unroll
        for (int ai = 0; ai < 2; ++ai)
#pragma unroll
            for (int m = 0; m < 4; ++m) { bf16_t* dst = Hf + (size_t)(u.pm * 256 + ai * 128 + wr * 64 + m * 16 + fr) * DFF + 128 * u.pn + 16 * wc + 4 * fq;
#pragma unroll
                for (int bj = 0; bj < 2; ++bj) { const f32x4 g = acc[ai][bj][m][0], up = acc[ai][bj][m][1]; f32x4 h;
#pragma unroll
                    for (int j = 0; j < 4; ++j) h[j] = g[j] * sigmoidf_(g[j]) * up[j];
                    *(u32x2*)(dst + 64 * bj) = pack4(h); } }
    }
};
struct PairedOrder {
    StaticOrder base; int dM, dN;
    __device__ bool next(int i, Unit& u) const { if (!base.next(i >> 1, u)) return false; if (i & 1) { u.pm += dM; u.pn += dN; } return true; }
    __device__ __forceinline__ void a_ready(const Unit&) const {}
    __device__ __forceinline__ void done(const Unit&) const {}
};
template <class Epi, class Sched, bool ALIGN_EPI = false, bool SP2 = false>
__device__ __forceinline__ void gemm_phase(PG8_LAS unsigned char* lds, const Gemm g, const Sched& S, const Epi& E) {
    int tid_ = threadIdx.x; asm volatile("" : "+v"(tid_));
    const int tid = tid_, wid = __builtin_amdgcn_readfirstlane(tid >> 6), lane = tid & 63, wr = wid >> 2, wc = wid & 3, fr = lane & 15, fq = lane >> 4;
    const int K = g.K, nt = K / BK;
    unsigned voffA[2], voffB[2];
#pragma unroll
    for (int i = 0; i < 2; ++i) { int R, C; stage_rc(tid * 16 + i * 8192, R, C); const int Rb = Epi::PERM ? ((R & ~31) + perm32(R & 31)) : R;
        voffA[i] = (unsigned)(R * K + C) * 2u; voffB[i] = (unsigned)(Rb * K + C) * 2u; }
    const size_t kstep = (size_t)(BK * 2);
    const size_t hstep = (size_t)HALF * K * 2;
    const size_t tstep = 2 * hstep;
    const unsigned ldsw = (unsigned)wid * 1024u;
    const int aoff = lds_byte(wr * 64 + fr, fq * 8), boff = lds_byte(wc * 32 + fr, fq * 8);
#define PG8_SA(b, h) (((b) * 2 + (h)) * HTB)
#define PG8_SB(b, h) ((4 + (b) * 2 + (h)) * HTB)
#define PG8_STAGE(bufoff, gbase, voff) do { _Pragma("unroll") for (int _i = 0; _i < 2; ++_i) \
        __builtin_amdgcn_global_load_lds((const unsigned*)((const char*)(gbase) + (voff)[_i]), (PG8_LAS unsigned*)(lds + (bufoff) + ldsw + _i * 8192), 16, 0, 0); } while (0)
#define PG8_LDA(dst, b, h) do { _Pragma("unroll") for (int m = 0; m < 4; ++m) _Pragma("unroll") for (int k = 0; k < 2; ++k) dst[m][k] = *(const PG8_LAS bf16x8*)(lds + PG8_SA(b, h) + aoff + m * 2048 + k * 1024); } while (0)
#define PG8_LDB(dst, b, h) do { _Pragma("unroll") for (int n = 0; n < 2; ++n) _Pragma("unroll") for (int k = 0; k < 2; ++k) dst[n][k] = *(const PG8_LAS bf16x8*)(lds + PG8_SB(b, h) + boff + n * 2048 + k * 1024); } while (0)
#define PG8_MMA(ai, bj, At, Bt) do { __builtin_amdgcn_s_setprio(1); _Pragma("unroll") for (int m = 0; m < 4; ++m) _Pragma("unroll") for (int n = 0; n < 2; ++n) _Pragma("unroll") for (int k = 0; k < 2; ++k) \
        acc[ai][bj][m][n] = __builtin_amdgcn_mfma_f32_16x16x32_bf16(Bt[n][k], At[m][k], acc[ai][bj][m][n], 0, 0, 0); __builtin_amdgcn_s_setprio(0); } while (0)
#define PG8_WAIT_V(n) asm volatile("s_waitcnt vmcnt(" #n ")" ::: "memory")
#define PG8_WAIT_L(n) asm volatile("s_waitcnt lgkmcnt(" #n ")" ::: "memory")
#define PG8_BAR __builtin_amdgcn_s_barrier()
#define PG8_SCHED __builtin_amdgcn_sched_barrier(0)
    Unit cur, nxt; int ui = 0;
    if (!S.next(0, cur)) return;
    f32x4 acc[2][2][4][2];
#pragma unroll
    for (int a = 0; a < 2; ++a)
#pragma unroll
        for (int b = 0; b < 2; ++b)
#pragma unroll
            for (int m = 0; m < 4; ++m)
#pragma unroll
                for (int n = 0; n < 2; ++n) acc[a][b][m][n] = (f32x4){0.f, 0.f, 0.f, 0.f};
    bf16x8 At[4][2], B0[2][2], B1[2][2];
    const char* cA = (const char*)g.A + (size_t)cur.pm * tstep; const char* cB = (const char*)g.Bt + (size_t)cur.pn * tstep;
    S.a_ready(cur);
    if constexpr (SP2) {
        PG8_STAGE(PG8_SB(0, 0), cB, voffB); PG8_STAGE(PG8_SB(0, 1), cB + hstep, voffB); PG8_STAGE(PG8_SA(0, 0), cA, voffA); PG8_STAGE(PG8_SA(0, 1), cA + hstep, voffA);
        if (wr == 1) PG8_BAR;
        PG8_WAIT_V(2); PG8_BAR;
        PG8_STAGE(PG8_SB(1, 0), cB + kstep, voffB); PG8_STAGE(PG8_SA(1, 0), cA + kstep, voffA); PG8_STAGE(PG8_SB(1, 1), cB + hstep + kstep, voffB);
        PG8_WAIT_V(6); PG8_BAR;
    } else {
        PG8_STAGE(PG8_SB(0, 0), cB, voffB); PG8_STAGE(PG8_SA(0, 0), cA, voffA); PG8_STAGE(PG8_SB(0, 1), cB + hstep, voffB); PG8_STAGE(PG8_SA(0, 1), cA + hstep, voffA);
        if (wr == 1) PG8_BAR;
        PG8_WAIT_V(4); PG8_BAR;
        PG8_STAGE(PG8_SB(1, 0), cB + kstep, voffB); PG8_STAGE(PG8_SA(1, 0), cA + kstep, voffA); PG8_STAGE(PG8_SB(1, 1), cB + hstep + kstep, voffB);
        PG8_WAIT_V(6); PG8_BAR;
    }
    for (;;) {
        const bool has_next = S.next(ui + 1, nxt);
        const char* nA = has_next ? (const char*)g.A + (size_t)nxt.pm * tstep : cA; const char* nB = has_next ? (const char*)g.Bt + (size_t)nxt.pn * tstep : cB;
        for (int t = 0; t < nt; t += 2) {
            const bool last = (t == nt - 2);
            const char* a1 = cA + (size_t)(t + 1) * kstep;
            const char* a2 = last ? nA : cA + (size_t)(t + 2) * kstep; const char* b2 = last ? nB : cB + (size_t)(t + 2) * kstep;
            const char* a3 = a2 + kstep; const char* b3 = b2 + kstep;
            if (last && has_next) S.a_ready(nxt);
            if constexpr (SP2) {
            PG8_LDB(B0, 0, 0); PG8_LDB(B1, 0, 1); PG8_SCHED; PG8_LDA(At, 0, 0); PG8_STAGE(PG8_SA(1, 1), a1 + hstep, voffA);
            PG8_WAIT_V(8); PG8_WAIT_L(0); PG8_BAR; PG8_MMA(0, 0, At, B0); PG8_MMA(0, 1, At, B1); PG8_BAR; PG8_SCHED;
            PG8_LDA(At, 0, 1); PG8_STAGE(PG8_SB(0, 0), b2, voffB); PG8_STAGE(PG8_SB(0, 1), b2 + hstep, voffB); PG8_STAGE(PG8_SA(0, 0), a2, voffA);
            PG8_WAIT_V(8); PG8_WAIT_L(0); PG8_BAR; PG8_MMA(1, 0, At, B0); PG8_MMA(1, 1, At, B1); PG8_BAR; PG8_SCHED;
            PG8_LDB(B0, 1, 0); PG8_LDB(B1, 1, 1); PG8_SCHED; PG8_LDA(At, 1, 0); PG8_STAGE(PG8_SA(0, 1), a2 + hstep, voffA);
            PG8_WAIT_V(8); PG8_WAIT_L(0); PG8_BAR; PG8_MMA(0, 0, At, B0); PG8_MMA(0, 1, At, B1); PG8_BAR; PG8_SCHED;
            PG8_LDA(At, 1, 1); PG8_STAGE(PG8_SB(1, 0), b3, voffB); PG8_STAGE(PG8_SB(1, 1), b3 + hstep, voffB); PG8_STAGE(PG8_SA(1, 0), a3, voffA);
            PG8_WAIT_V(8); PG8_WAIT_L(0); PG8_BAR; PG8_MMA(1, 0, At, B0); PG8_MMA(1, 1, At, B1); PG8_BAR; PG8_SCHED;
            } else {
            PG8_LDB(B0, 0, 0); PG8_SCHED; PG8_LDA(At, 0, 0); PG8_STAGE(PG8_SA(1, 1), a1 + hstep, voffA);
            PG8_WAIT_L(8); PG8_BAR; PG8_WAIT_L(0); PG8_MMA(0, 0, At, B0); PG8_BAR; PG8_SCHED;
            PG8_LDB(B1, 0, 1); PG8_STAGE(PG8_SB(0, 0), b2, voffB);
            PG8_BAR; PG8_WAIT_L(0); PG8_MMA(0, 1, At, B1); PG8_BAR;
            PG8_LDA(At, 0, 1); PG8_STAGE(PG8_SA(0, 0), a2, voffA);
            PG8_BAR; PG8_WAIT_L(0); PG8_MMA(1, 0, At, B0); PG8_BAR; PG8_SCHED;
            PG8_STAGE(PG8_SB(0, 1), b2 + hstep, voffB);
            PG8_WAIT_V(6); PG8_BAR; PG8_MMA(1, 1, At, B1); PG8_BAR;
            PG8_LDB(B0, 1, 0); PG8_SCHED; PG8_LDA(At, 1, 0); PG8_STAGE(PG8_SA(0, 1), a2 + hstep, voffA);
            PG8_WAIT_L(8); PG8_BAR; PG8_WAIT_L(0); PG8_MMA(0, 0, At, B0); PG8_BAR; PG8_SCHED;
            PG8_LDB(B1, 1, 1); PG8_STAGE(PG8_SB(1, 0), b3, voffB);
            PG8_BAR; PG8_WAIT_L(0); PG8_MMA(0, 1, At, B1); PG8_BAR;
            PG8_LDA(At, 1, 1); PG8_STAGE(PG8_SA(1, 0), a3, voffA);
            PG8_BAR; PG8_WAIT_L(0); PG8_MMA(1, 0, At, B0); PG8_BAR; PG8_SCHED;
            PG8_STAGE(PG8_SB(1, 1), b3 + hstep, voffB);
            PG8_WAIT_V(6); PG8_BAR; PG8_MMA(1, 1, At, B1); PG8_BAR;
            }
        }
        if constexpr (ALIGN_EPI) { if (wr == 0) PG8_BAR; }
        if constexpr (!Epi::AFTER_DRAIN) { E(acc, cur, wr, wc, fr, fq); S.done(cur); }
        if (!has_next) break;
        if (!Epi::keep(cur))
#pragma unroll
        for (int a = 0; a < 2; ++a)
#pragma unroll
            for (int b = 0; b < 2; ++b)
#pragma unroll
                for (int m = 0; m < 4; ++m)
#pragma unroll
                    for (int n = 0; n < 2; ++n) acc[a][b][m][n] = (f32x4){0.f, 0.f, 0.f, 0.f};
        cur = nxt; cA = nA; cB = nB; ++ui;
        if constexpr (ALIGN_EPI) { if (wr == 1) PG8_BAR; }
    }
    PG8_WAIT_V(0);
    if constexpr (!ALIGN_EPI) { if (wr == 0) PG8_BAR; }
    PG8_BAR;
    if constexpr (Epi::AFTER_DRAIN) { E.fused(acc, cur, wr, wc, fr, fq, lds, wid, lane); S.done(cur); }
#undef PG8_SA
#undef PG8_SB
#undef PG8_STAGE
#undef PG8_LDA
#undef PG8_LDB
#undef PG8_MMA
#undef PG8_WAIT_V
#undef PG8_WAIT_L
#undef PG8_BAR
#undef PG8_SCHED
}
}
#define GAS __attribute__((address_space(1)))
#define LAS __attribute__((address_space(3)))
typedef unsigned short bf16;
typedef unsigned v4u __attribute__((ext_vector_type(4)));
typedef unsigned v2u __attribute__((ext_vector_type(2)));
typedef float f32x4 __attribute__((ext_vector_type(4)));
typedef float f32x16 __attribute__((ext_vector_type(16)));
typedef short bf16x8 __attribute__((ext_vector_type(8)));
typedef short s16x4 __attribute__((ext_vector_type(4)));
constexpr int NWAVES = 8, NTHR = 512;
constexpr int RING_BYTES = 131072, LDS_BYTES = 147456;
constexpr size_t MiB = 1u << 20;
constexpr size_t WS_MOD = 1 * MiB, WS_ROPE = 1 * MiB + 512 * 1024, WS_W = 2 * MiB, WL_STRIDE = 27 * MiB + 512 * 1024;
constexpr size_t WO_IN = 0, WO_P = 7 * MiB, WO_O = 9 * MiB, WO_GU = 11 * MiB, WO_D = 22 * MiB;
constexpr size_t WS_X = 112 * MiB, WS_H = 180 * MiB, WS_Q = 214 * MiB, WS_K = 248 * MiB, WS_VT = 256 * MiB + 512 * 1024, WS_SG = 265 * MiB, WS_Y = 333 * MiB, WS_HF = 265 * MiB, WS_END = 367 * MiB;
static_assert(WS_W + DEPTH * WL_STRIDE <= WS_X && WS_X + (size_t)MALL * DM * 4 <= WS_H && WS_H + (size_t)MALL * DM * 2 <= WS_Q && WS_Q + (size_t)2 * NB * 8 * SALL * 64 * 2 <= WS_K, "ws map 1");
static_assert(WS_K + (size_t)2 * NB * 2 * SALL * 64 * 2 <= WS_VT && WS_VT + (size_t)2 * NB * 2 * SALL * 64 * 2 <= WS_SG && WS_SG + (size_t)2 * MALL * DM * 2 <= WS_Y && WS_Y + (size_t)2 * MALL * 512 * 2 <= WS_END && WS_HF + (size_t)MALL * DFF * 2 <= WS_END, "ws map 2");

struct Args { const float* in[19]; float* out; unsigned char* ws; };
struct Frame { LAS unsigned char* lds; int tid, lane, wave, G, bid; };

__device__ __forceinline__ unsigned f2bf(float f) { unsigned u = __builtin_bit_cast(unsigned, f); return (u + 0x7fffu + ((u >> 16) & 1u)) >> 16; }
__device__ __forceinline__ unsigned pk2(float lo, float hi) { return f2bf(lo) | (f2bf(hi) << 16); }
__device__ __forceinline__ float wave_sum(float v) {
#pragma unroll
    for (int o = 1; o < 64; o <<= 1) v += __shfl_xor(v, o);
    return v;
}
__device__ __forceinline__ int wrow_map(int mode, int n) {
    if (mode == 1) return ((n >> 8) << 8) + (((n & 63) >> 5) << 7) + (((n >> 6) & 3) << 5) + (n & 31);
    if (mode == 2) return ((n >> 4) << 5) + (n & 15);
    if (mode == 3) return ((n >> 4) << 5) + 16 + (n & 15);
    return n;
}
__device__ __forceinline__ void transpose_item(const float* W, int K, int N, bf16* WT, int row_off, int mode, LAS float* scr, int item, int lane) {
    const int nblk = N / 32, kb = item / nblk, nb = item % nblk, k0 = 64 * kb, n0 = 32 * nb;
#pragma unroll 8
    for (int i = 0; i < 32; ++i) { const int kk = 2 * i + (lane >> 5); scr[kk * 33 + (lane & 31)] = W[(size_t)(k0 + kk) * N + n0 + (lane & 31)]; }
    asm volatile("s_waitcnt lgkmcnt(0)" ::: "memory");
    const int c = lane & 7;
#pragma unroll
    for (int j = 0; j < 4; ++j) { const int n = (lane >> 3) + 8 * j; const LAS float* s = scr + (8 * c) * 33 + n;
        v4u o; o.x = pk2(s[0 * 33], s[1 * 33]); o.y = pk2(s[2 * 33], s[3 * 33]); o.z = pk2(s[4 * 33], s[5 * 33]); o.w = pk2(s[6 * 33], s[7 * 33]);
        *(v4u*)(WT + (size_t)(row_off + wrow_map(mode, n0 + n)) * K + k0 + 8 * c) = o; }
    asm volatile("s_waitcnt lgkmcnt(0)" ::: "memory");
}
__device__ __forceinline__ void prologue(const Frame& F, const Args& a) {
    unsigned char* ws = a.ws;
    LAS float* sv = (LAS float*)F.lds; LAS float* part = (LAS float*)(F.lds + 20480);
    for (int i = F.tid; i < 5 * 1024; i += NTHR) { const int v = i >> 10, k = i & 1023; const float cv = v < 4 ? a.in[1][v * 1024 + k] : a.in[3][k]; sv[i] = cv / (1.0f + expf(-cv)); }
    __syncthreads();
    float* mod = (float*)(ws + WS_MOD);
    for (int item = F.bid; item < DEPTH * 96; item += F.G) {
        const int l = item / 96, n0 = (item % 96) * 64, k0 = F.wave * 128;
        const float* W = a.in[4] + (size_t)l * 1024 * 6144 + (size_t)k0 * 6144 + n0 + F.lane;
        float a0 = 0.f, a1 = 0.f, a2 = 0.f, a3 = 0.f, a4 = 0.f;
#pragma unroll 8
        for (int kk = 0; kk < 128; ++kk) { const float w = W[(size_t)kk * 6144]; const int k = k0 + kk;
            a0 += sv[k] * w; a1 += sv[1024 + k] * w; a2 += sv[2048 + k] * w; a3 += sv[3072 + k] * w; a4 += sv[4096 + k] * w; }
        part[(F.wave * 5 + 0) * 64 + F.lane] = a0; part[(F.wave * 5 + 1) * 64 + F.lane] = a1; part[(F.wave * 5 + 2) * 64 + F.lane] = a2;
        part[(F.wave * 5 + 3) * 64 + F.lane] = a3; part[(F.wave * 5 + 4) * 64 + F.lane] = a4;
        __syncthreads();
        if (F.tid < 320) { const int v = F.tid >> 6, ln = F.tid & 63; float s = a.in[5][l * 6144 + n0 + ln];
#pragma unroll
            for (int w = 0; w < 8; ++w) s += part[(w * 5 + v) * 64 + ln];
            mod[(size_t)(l * 5 + v) * 6144 + n0 + ln] = s; }
        __syncthreads();
    }
    if (F.bid == F.G - 1) { float* rc = (float*)(ws + WS_ROPE); float* rs = rc + 1024;
        for (int i = F.tid; i < 1024; i += NTHR) { const int pos = i >> 4, j = i & 15; const float inv = powf(10000.0f, -(float)j / 16.0f); const float ang = (float)pos * inv; rc[i] = cosf(ang); rs[i] = sinf(ang); } }
    __syncthreads();
    LAS float* scr = (LAS float*)(F.lds + F.wave * 16384);
    const int gw = F.bid * NWAVES + F.wave, NGW = F.G * NWAVES;
    constexpr int I_IN = 16 * 112, I_P = 8 * 32, I_O = 16 * 32, I_G = 16 * 88, I_D = 44 * 32, I_L = I_IN + 2 * I_P + I_O + 2 * I_G + I_D;
    for (int it = gw; it < DEPTH * I_L; it += NGW) {
        const int l = it / I_L; int r = it % I_L; unsigned char* wl = ws + WS_W + (size_t)l * WL_STRIDE;
        if (r < I_IN) { transpose_item(a.in[8] + (size_t)l * 1024 * INC, 1024, INC, (bf16*)(wl + WO_IN), 0, 1, scr, r, F.lane); continue; } r -= I_IN;
        if (r < I_P) { transpose_item(a.in[12] + (size_t)l * 512 * 1024, 512, 1024, (bf16*)(wl + WO_P), 0, 0, scr, r, F.lane); continue; } r -= I_P;
        if (r < I_P) { transpose_item(a.in[13] + (size_t)l * 512 * 1024, 512, 1024, (bf16*)(wl + WO_P), 1024, 0, scr, r, F.lane); continue; } r -= I_P;
        if (r < I_O) { transpose_item(a.in[14] + (size_t)l * 1024 * 1024, 1024, 1024, (bf16*)(wl + WO_O), 0, 0, scr, r, F.lane); continue; } r -= I_O;
        if (r < I_G) { transpose_item(a.in[15] + (size_t)l * 1024 * DFF, 1024, DFF, (bf16*)(wl + WO_GU), 0, 2, scr, r, F.lane); continue; } r -= I_G;
        if (r < I_G) { transpose_item(a.in[16] + (size_t)l * 1024 * DFF, 1024, DFF, (bf16*)(wl + WO_GU), 0, 3, scr, r, F.lane); continue; } r -= I_G;
        transpose_item(a.in[17] + (size_t)l * DFF * 1024, DFF, 1024, (bf16*)(wl + WO_D), 0, 0, scr, r, F.lane);
    }
}
__device__ __forceinline__ void norm_phase(const Frame& F, const float* xl, const float* xc, float* Xcopy, bf16* H, const float* g, const float* modl, int shidx, int M) {
    const int gw = F.bid * NWAVES + F.wave, NGW = F.G * NWAVES;
    f32x4 gv[4];
#pragma unroll
    for (int j = 0; j < 4; ++j) gv[j] = *(const f32x4*)(g + 4 * F.lane + 256 * j);
    for (int row = gw; row < M; row += NGW) {
        const int v = row < MLAT ? row >> 12 : 4;
        const float* xr = row < MLAT ? xl + (size_t)row * DM : xc + (size_t)(row - MLAT) * DM;
        f32x4 x[4]; float ss = 0.f;
#pragma unroll
        for (int j = 0; j < 4; ++j) { x[j] = *(const f32x4*)(xr + 4 * F.lane + 256 * j); ss += (x[j][0] * x[j][0] + x[j][1] * x[j][1]) + (x[j][2] * x[j][2] + x[j][3] * x[j][3]); }
        const float rstd = 1.0f / sqrtf(wave_sum(ss) * (1.0f / DM) + NORM_EPS);
        const float* mv = modl + v * 6144 + shidx * 1024;
#pragma unroll
        for (int j = 0; j < 4; ++j) { const int col = 4 * F.lane + 256 * j; const f32x4 sh = *(const f32x4*)(mv + col), sc = *(const f32x4*)(mv + 1024 + col);
            const f32x4 h = ((x[j] * rstd) * gv[j]) * (sc + 1.0f) + sh;
            v2u w; w.x = pk2(h[0], h[1]); w.y = pk2(h[2], h[3]); *(v2u*)(H + (size_t)row * DM + col) = w;
            if (Xcopy) *(f32x4*)(Xcopy + (size_t)row * DM + col) = x[j]; }
    }
}
__device__ __forceinline__ void final_norm(const Frame& F, const float* X, float* out, const float* g) {
    const int gw = F.bid * NWAVES + F.wave, NGW = F.G * NWAVES;
    f32x4 gv[4];
#pragma unroll
    for (int j = 0; j < 4; ++j) gv[j] = *(const f32x4*)(g + 4 * F.lane + 256 * j);
    for (int row = gw; row < MLAT; row += NGW) {
        const float* xr = X + (size_t)row * DM; f32x4 x[4]; float ss = 0.f;
#pragma unroll
        for (int j = 0; j < 4; ++j) { x[j] = *(const f32x4*)(xr + 4 * F.lane + 256 * j); ss += (x[j][0] * x[j][0] + x[j][1] * x[j][1]) + (x[j][2] * x[j][2] + x[j][3] * x[j][3]); }
        const float rstd = 1.0f / sqrtf(wave_sum(ss) * (1.0f / DM) + NORM_EPS);
#pragma unroll
        for (int j = 0; j < 4; ++j) *(f32x4*)(out + (size_t)row * DM + 4 * F.lane + 256 * j) = (x[j] * rstd) * gv[j];
    }
}
constexpr int AK_PITCH = 144, AV_PITCH = 136, AK_BYTES = 64 * AK_PITCH, AV_BYTES = 64 * AV_PITCH, AV_OFF = 2 * AK_BYTES;
typedef float f32x2_t __attribute__((ext_vector_type(2))); typedef __bf16 bf16x2_t __attribute__((ext_vector_type(2)));
__device__ __forceinline__ unsigned cvtpk(float lo, float hi) { f32x2_t v = {lo, hi}; bf16x2_t b = __builtin_convertvector(v, bf16x2_t); return __builtin_bit_cast(unsigned, b); }
#define MX3(a, b, c) __builtin_fmaxf(__builtin_fmaxf((a), (b)), (c))
constexpr float ATT_THR = 8.0f;
__device__ __forceinline__ void attn_unit(const Frame& F, const bf16* Qb, const bf16* Kb, const bf16* VTb, bf16* Yb, int kvh, int qs, int yrow0, int ta, int tb, bool wmask, bool has_sink, const float* sink) {
    const int tid = F.tid, lane = F.lane, r32 = lane & 31, hi = lane >> 5, wave = F.wave;
    const int head = kvh * 4 + (wave >> 1), qrow = qs + 32 * (wave & 1) + r32;
    const bf16* qp = Qb + ((size_t)head * SALL + qrow) * 64 + hi * 8;
    bf16x8 qr[4];
#pragma unroll
    for (int d0 = 0; d0 < 4; ++d0) qr[d0] = *(const bf16x8*)(qp + 16 * d0);
    const int nl = tb - ta, nt = nl + 4, qt = qs >> 6;
    const int srow = tid >> 3, sch = tid & 7;
    const bf16* kg = Kb + (size_t)srow * 64 + sch * 8;
    const bf16* vg = VTb + (size_t)srow * SALL + sch * 8;
    LAS unsigned char* kw = F.lds + srow * AK_PITCH + sch * 16;
    LAS unsigned char* vw = F.lds + AV_OFF + srow * AV_PITCH + sch * 16;
#define ATT_TILE(i) ((i) < nl ? ta + (i) : 64 + (i) - nl)
    v4u kreg, vreg;
    { const int t = ATT_TILE(0); kreg = *(const v4u*)(kg + (size_t)t * 4096); vreg = *(const v4u*)(vg + t * 64); }
    *(LAS v4u*)kw = kreg; *(LAS v2u*)vw = (v2u){vreg.x, vreg.y}; *(LAS v2u*)(vw + 8) = (v2u){vreg.z, vreg.w};
    const float sink2 = has_sink ? sink[head] * LOG2E : 0.0f;
    float mref = sink2, lrun = 0.f;
    f32x16 o0, o1, negm;
#pragma unroll
    for (int r = 0; r < 16; ++r) { o0[r] = 0.f; o1[r] = 0.f; negm[r] = -mref; }
    __syncthreads();
    for (int i = 0; i < nt; ++i) {
        const int cur = i & 1, t = ATT_TILE(i);
        const bool more = i + 1 < nt;
        if (more) { const int t2 = ATT_TILE(i + 1); kreg = *(const v4u*)(kg + (size_t)t2 * 4096); vreg = *(const v4u*)(vg + t2 * 64); }
        f32x16 s0 = negm, s1 = negm;
        const LAS unsigned char* kb = F.lds + cur * AK_BYTES + r32 * AK_PITCH + hi * 16;
#pragma unroll
        for (int d0 = 0; d0 < 4; ++d0) { const bf16x8 k0 = *(const LAS bf16x8*)(kb + d0 * 32), k1 = *(const LAS bf16x8*)(kb + 32 * AK_PITCH + d0 * 32);
            s0 = __builtin_amdgcn_mfma_f32_32x32x16_bf16(k0, qr[d0], s0, 0, 0, 0); s1 = __builtin_amdgcn_mfma_f32_32x32x16_bf16(k1, qr[d0], s1, 0, 0, 0); }
        if (wmask && t < 64 && (t == qt - 2 || t == qt + 2)) {
            const int kb0 = t * 64 + 4 * hi - qrow;
#pragma unroll
            for (int r = 0; r < 16; ++r) { const int rel = kb0 + (r & 3) + 8 * (r >> 2); if (rel > 128 || rel < -128) s0[r] = -1e30f; if (rel + 32 > 128 || rel + 32 < -128) s1[r] = -1e30f; }
        }
        float ma = MX3(s0[0], s0[1], s1[0]), mb = MX3(s0[2], s0[3], s1[1]); ma = MX3(ma, s1[2], s1[3]);
#pragma unroll
        for (int r = 4; r < 16; r += 4) { ma = MX3(ma, s0[r], s0[r + 1]); mb = MX3(mb, s0[r + 2], s0[r + 3]); ma = MX3(ma, s1[r], s1[r + 1]); mb = MX3(mb, s1[r + 2], s1[r + 3]); }
        float rm = __builtin_fmaxf(ma, mb); rm = __builtin_fmaxf(rm, __shfl_xor(rm, 32));
        const bool first = (i == 0) && !has_sink;
        if (first || __any(rm > ATT_THR)) {
            const float dl = first ? rm : __builtin_fmaxf(rm, 0.f);
            mref += dl;
#pragma unroll
            for (int r = 0; r < 16; ++r) { s0[r] -= dl; s1[r] -= dl; negm[r] = -mref; }
            if (!first) { const float f = __builtin_amdgcn_exp2f(-dl); lrun *= f;
#pragma unroll
                for (int r = 0; r < 16; ++r) { o0[r] *= f; o1[r] *= f; } }
        }
        f32x2_t ls2 = {0.f, 0.f};
#pragma unroll
        for (int r = 0; r < 16; r += 2) { s0[r] = __builtin_amdgcn_exp2f(s0[r]); s0[r + 1] = __builtin_amdgcn_exp2f(s0[r + 1]); s1[r] = __builtin_amdgcn_exp2f(s1[r]); s1[r + 1] = __builtin_amdgcn_exp2f(s1[r + 1]);
            ls2 += (f32x2_t){s0[r], s0[r + 1]}; ls2 += (f32x2_t){s1[r], s1[r + 1]}; }
        lrun += ls2.x + ls2.y;
        bf16x8 pf[4];
#pragma unroll
        for (int c = 0; c < 2; ++c) { v4u w0, w1;
            w0.x = cvtpk(s0[8 * c + 0], s0[8 * c + 1]); w0.y = cvtpk(s0[8 * c + 2], s0[8 * c + 3]); w0.z = cvtpk(s0[8 * c + 4], s0[8 * c + 5]); w0.w = cvtpk(s0[8 * c + 6], s0[8 * c + 7]);
            w1.x = cvtpk(s1[8 * c + 0], s1[8 * c + 1]); w1.y = cvtpk(s1[8 * c + 2], s1[8 * c + 3]); w1.z = cvtpk(s1[8 * c + 4], s1[8 * c + 5]); w1.w = cvtpk(s1[8 * c + 6], s1[8 * c + 7]);
            pf[c] = __builtin_bit_cast(bf16x8, w0); pf[2 + c] = __builtin_bit_cast(bf16x8, w1); }
        const LAS unsigned char* vb = F.lds + AV_OFF + cur * AV_BYTES + r32 * AV_PITCH + hi * 8;
#pragma unroll
        for (int c = 0; c < 4; ++c) {
            const s16x4 a0 = *(const LAS s16x4*)(vb + c * 32), a1 = *(const LAS s16x4*)(vb + c * 32 + 16);
            const s16x4 b0 = *(const LAS s16x4*)(vb + 32 * AV_PITCH + c * 32), b1 = *(const LAS s16x4*)(vb + 32 * AV_PITCH + c * 32 + 16);
            const bf16x8 va = (bf16x8){a0[0], a0[1], a0[2], a0[3], a1[0], a1[1], a1[2], a1[3]}, vb8 = (bf16x8){b0[0], b0[1], b0[2], b0[3], b1[0], b1[1], b1[2], b1[3]};
            o0 = __builtin_amdgcn_mfma_f32_32x32x16_bf16(va, pf[c], o0, 0, 0, 0); o1 = __builtin_amdgcn_mfma_f32_32x32x16_bf16(vb8, pf[c], o1, 0, 0, 0);
        }
        if (more) { const int nb = cur ^ 1; *(LAS v4u*)(kw + nb * AK_BYTES) = kreg; *(LAS v2u*)(vw + nb * AV_BYTES) = (v2u){vreg.x, vreg.y}; *(LAS v2u*)(vw + nb * AV_BYTES + 8) = (v2u){vreg.z, vreg.w}; }
        __syncthreads();
    }
#undef ATT_TILE
    lrun += __shfl_xor(lrun, 32);
    if (has_sink) lrun += __builtin_amdgcn_exp2f(sink2 - mref);
    const float inv = 1.0f / lrun;
    bf16* yp = Yb + (size_t)(yrow0 + 32 * (wave & 1) + r32) * 512 + head * 64 + 4 * hi;
#pragma unroll
    for (int r4 = 0; r4 < 4; ++r4) { v2u w; w.x = cvtpk(o0[4 * r4] * inv, o0[4 * r4 + 1] * inv); w.y = cvtpk(o0[4 * r4 + 2] * inv, o0[4 * r4 + 3] * inv); *(v2u*)(yp + 8 * r4) = w;
        w.x = cvtpk(o1[4 * r4] * inv, o1[4 * r4 + 1] * inv); w.y = cvtpk(o1[4 * r4 + 2] * inv, o1[4 * r4 + 3] * inv); *(v2u*)(yp + 32 + 8 * r4) = w; }
}
__device__ __forceinline__ void attn_phase(const Frame& F, const bf16* Q, const bf16* K, const bf16* VT, bf16* Y, const float* sink, int nunits) {
    for (int U = F.bid; U < nunits; U += F.G) {
        int br, grp, qblk; bool isctx = false;
        if (U < 512) { br = 1; grp = U & 7; qblk = U >> 3; }
        else if (U < 1024) { br = 0; grp = U & 7; qblk = (U - 512) >> 3; }
        else { const int u2 = U - 1024; isctx = true; br = u2 >> 5; grp = (u2 >> 2) & 7; qblk = u2 & 3; }
        const int b = grp >> 1, kvh = grp & 1;
        const bf16* Qb = Q + (size_t)(br * NB + b) * 8 * SALL * 64;
        const bf16* Kb = K + (size_t)((br * NB + b) * 2 + kvh) * SALL * 64;
        const bf16* VTb = VT + (size_t)((br * NB + b) * 2 + kvh) * 64 * SALL;
        bf16* Yb = Y + (size_t)br * MALL * 512;
        int ta = 0, tb = 0; bool wmask = false;
        if (!isctx) { if (br == 1) { ta = 0; tb = 64; } else { ta = qblk - 2 < 0 ? 0 : qblk - 2; tb = qblk + 3 > 64 ? 64 : qblk + 3; wmask = true; } }
        const int qs = isctx ? SEQ + 64 * qblk : 64 * qblk;
        const int yrow0 = isctx ? MLAT + b * CTXL + 64 * qblk : b * SEQ + 64 * qblk;
        attn_unit(F, Qb, Kb, VTb, Yb, kvh, qs, yrow0, ta, tb, wmask, br == 0, sink);
    }
}
typedef GAS unsigned gu32;
typedef GAS unsigned long long gu64;
#define RLX_AGENT __ATOMIC_RELAXED, __HIP_MEMORY_SCOPE_AGENT
#define XB_TMO      128
#define XB_XCNT(j)  (256  + 64 * (j))
#define XB_XSUB(j)  (1280 + 64 * (j))
#define XB_XGEN(j)  (2304 + 64 * (j))
#define XB_TOP      3328
#define XB_TOPGEN   3392
#define XCD_BAR_WORDS 3456
#define XB_SPIN_CAP (1u << 18)

__device__ __forceinline__ unsigned xb_ld(unsigned* p)              { return __hip_atomic_load(p, __ATOMIC_RELAXED, __HIP_MEMORY_SCOPE_AGENT); }
__device__ __forceinline__ unsigned xb_add(unsigned* p, unsigned v) { return __hip_atomic_fetch_add(p, v, __ATOMIC_RELAXED, __HIP_MEMORY_SCOPE_AGENT); }
__device__ __forceinline__ unsigned xb_xcc_id() { return (unsigned)__builtin_amdgcn_s_getreg((3 << 11) | 20) & 0xFu; }
#define XB_SPIN(cond, bar) do { unsigned _sp = 0; while (cond) { __builtin_amdgcn_s_sleep(1); \
    if ((++_sp & 255u) == 0u) { if (xb_ld(&(bar)[XB_TMO])) break; if (_sp > XB_SPIN_CAP) { atomicAdd(&(bar)[XB_TMO], 1u); break; } } } } while (0)

struct XcdBarrier {
    unsigned* bar; unsigned x;
    volatile LAS unsigned* st;
};

__device__ __forceinline__ XcdBarrier xcd_barrier_post(unsigned* bar, volatile LAS unsigned* st) {
    XcdBarrier b; b.bar = bar; b.x = xb_xcc_id(); b.st = st;
    if (threadIdx.x == 0) (void)xb_add(&bar[XB_XCNT(b.x)], 1u);
    return b;
}
__device__ __forceinline__ void xcd_barrier_complete(unsigned* bar, unsigned x, unsigned& nloc, unsigned& nx) {
    const unsigned G = gridDim.x * gridDim.y * gridDim.z;
    unsigned sum, cnt, mine, sp = 0u;
    for (;;) {
        sum = 0u; cnt = 0u; mine = 0u;
#pragma unroll
        for (unsigned j = 0; j < 16; ++j) { const unsigned c = xb_ld(&bar[XB_XCNT(j)]); sum += c; cnt += (c > 0u) ? 1u : 0u; mine = (j == x) ? c : mine; }
        if (sum == G) break;
        __builtin_amdgcn_s_sleep(1);
        if ((++sp & 255u) == 0u) { if (xb_ld(&bar[XB_TMO])) break; if (sp > XB_SPIN_CAP) { atomicAdd(&bar[XB_TMO], 1u); break; } }
    }
    nloc = mine > 0u ? mine : 1u; nx = cnt > 0u ? cnt : 1u;
}

__device__ __forceinline__ void xcd_barrier(const XcdBarrier& b) {
    asm volatile("s_waitcnt vmcnt(0)" ::: "memory");
    __syncthreads();
    if (threadIdx.x == 0) {
        unsigned* bar = b.bar;
        __builtin_amdgcn_s_waitcnt(0);
        unsigned nloc = b.st[0], nx = b.st[1];
        if (nloc == 0u) { xcd_barrier_complete(bar, b.x, nloc, nx); b.st[0] = nloc; b.st[1] = nx; }
        const unsigned old = xb_add(&bar[XB_XSUB(b.x)], 1u);
        const unsigned gen = old / nloc;
        if (old + 1u == (gen + 1u) * nloc) {
            __builtin_amdgcn_fence(__ATOMIC_RELEASE, "agent");
            asm volatile("s_waitcnt vmcnt(0)" ::: "memory");
            const unsigned og = xb_add(&bar[XB_TOP], 1u);
            const unsigned tg = og / nx;
            if (og + 1u == (tg + 1u) * nx) xb_add(&bar[XB_TOPGEN], 1u);
            else XB_SPIN(xb_ld(&bar[XB_TOPGEN]) == tg, bar);
            __builtin_amdgcn_fence(__ATOMIC_ACQUIRE, "agent");
            xb_add(&bar[XB_XGEN(b.x)], 1u);
            asm volatile("s_waitcnt vmcnt(0)" ::: "memory");
        } else {
            XB_SPIN(xb_ld(&bar[XB_XGEN(b.x)]) == gen, bar);
            __builtin_amdgcn_fence(__ATOMIC_ACQUIRE, "agent");
            asm volatile("s_waitcnt vmcnt(0)" ::: "memory");
        }
    }
    __syncthreads();
}

__device__ __forceinline__ void mini_block(const bf16* A, int lda, const bf16* Bt, int ldb, int K, f32x4& c0, f32x4& c1, int lane) {
    const int fr = lane & 15, fq = lane >> 4;
    const bf16* ap = A + (size_t)fr * lda + 8 * fq;
    const bf16* b0p = Bt + (size_t)fr * ldb + 8 * fq; const bf16* b1p = b0p + (size_t)16 * ldb;
    bf16x8 a0[4], p0[4], q0[4], a1[4], p1[4], q1[4];
#define MINI_LD(a, p, q, kk) do { _Pragma("unroll") for (int u = 0; u < 4; ++u) { a[u] = *(const bf16x8*)(ap + (kk) + 32 * u); p[u] = *(const bf16x8*)(b0p + (kk) + 32 * u); q[u] = *(const bf16x8*)(b1p + (kk) + 32 * u); } } while (0)
#define MINI_MM(a, p, q) do { _Pragma("unroll") for (int u = 0; u < 4; ++u) { c0 = __builtin_amdgcn_mfma_f32_16x16x32_bf16(p[u], a[u], c0, 0, 0, 0); c1 = __builtin_amdgcn_mfma_f32_16x16x32_bf16(q[u], a[u], c1, 0, 0, 0); } } while (0)
    MINI_LD(a0, p0, q0, 0);
    for (int k = 0; k < K; k += 256) {
        MINI_LD(a1, p1, q1, k + 128);
        MINI_MM(a0, p0, q0);
        if (k + 256 < K) MINI_LD(a0, p0, q0, k + 256);
        MINI_MM(a1, p1, q1);
    }
#undef MINI_LD
#undef MINI_MM
}
__device__ __forceinline__ unsigned long long pack4u(f32x4 v) { return (unsigned long long)pk2(v[0], v[1]) | ((unsigned long long)pk2(v[2], v[3]) << 32); }
__device__ __forceinline__ f32x4 unpack4u(v2u w) { f32x4 v; v[0] = __uint_as_float(w.x << 16); v[1] = __uint_as_float(w.x & 0xffff0000u); v[2] = __uint_as_float(w.y << 16); v[3] = __uint_as_float(w.y & 0xffff0000u); return v; }
__device__ __forceinline__ void ctx_merge_tiles(const Frame& F, const bf16* Y, const bf16* Wp, const bf16* SG, bf16* Mb) {
    const int fr = F.lane & 15, fq = F.lane >> 4, wi = F.wave >> 1, wj = F.wave & 1;
    for (int t = F.bid; t < 256; t += F.G) {
        const int row0 = MLAT + 64 * (t >> 4) + 16 * wi, col0 = 64 * (t & 15) + 32 * wj;
        f32x4 a0 = {0.f, 0.f, 0.f, 0.f}, a1 = a0, b0 = a0, b1 = a0;
        mini_block(Y + (size_t)row0 * 512, 512, Wp + (size_t)col0 * 512, 512, 512, a0, a1, F.lane);
        mini_block(Y + ((size_t)MALL + row0) * 512, 512, Wp + (size_t)(1024 + col0) * 512, 512, 512, b0, b1, F.lane);
        const size_t off = (size_t)(row0 + fr) * 1024 + col0 + 4 * fq;
        const f32x4 sa0 = unpack4u(*(const v2u*)(SG + off)), sa1 = unpack4u(*(const v2u*)(SG + off + 16));
        const f32x4 sb0 = unpack4u(*(const v2u*)(SG + (size_t)MALL * 1024 + off)), sb1 = unpack4u(*(const v2u*)(SG + (size_t)MALL * 1024 + off + 16));
        *(unsigned long long*)(Mb + off) = pack4u(sa0 * a0 + sb0 * b0); *(unsigned long long*)(Mb + off + 16) = pack4u(sa1 * a1 + sb1 * b1);
    }
}
__device__ __forceinline__ void ctx_resid_tiles(const Frame& F, const bf16* A, int K, const bf16* Bt, const float* gate_ctx, float* X) {
    const int fr = F.lane & 15, fq = F.lane >> 4, wi = F.wave >> 1, wj = F.wave & 1;
    for (int t = F.bid; t < 256; t += F.G) {
        const int row0 = MLAT + 64 * (t >> 4) + 16 * wi, col0 = 64 * (t & 15) + 32 * wj;
        f32x4 c0 = {0.f, 0.f, 0.f, 0.f}, c1 = c0;
        float* xp = X + (size_t)(row0 + fr) * 1024 + col0 + 4 * fq;
        const f32x4 x0 = *(const f32x4*)xp, x1 = *(const f32x4*)(xp + 16);
        const f32x4 g0 = *(const f32x4*)(gate_ctx + col0 + 4 * fq), g1 = *(const f32x4*)(gate_ctx + col0 + 4 * fq + 16);
        mini_block(A + (size_t)row0 * K, K, Bt + (size_t)col0 * K, K, K, c0, c1, F.lane);
        *(f32x4*)xp = x0 + g0 * c0; *(f32x4*)(xp + 16) = x1 + g1 * c1;
    }
}
__global__ void __launch_bounds__(NTHR, 2) fwd_megakernel(Args args) {
    extern __shared__ __attribute__((aligned(16))) unsigned char lds_raw[];
    cg::grid_group grid = cg::this_grid();
    Frame F;
#define MKFRAME() do { int t_ = threadIdx.x; asm volatile("" : "+v"(t_)); F.lds = (LAS unsigned char*)lds_raw; F.tid = t_; F.lane = t_ & 63; F.wave = __builtin_amdgcn_readfirstlane(t_ >> 6); F.G = gridDim.x; F.bid = blockIdx.x; } while (0)
    MKFRAME();
    unsigned char* ws = args.ws;
    float* X = (float*)(ws + WS_X); bf16* H = (bf16*)(ws + WS_H); bf16* Qb = (bf16*)(ws + WS_Q); bf16* Kb = (bf16*)(ws + WS_K); bf16* VTb = (bf16*)(ws + WS_VT);
    bf16* SG = (bf16*)(ws + WS_SG); bf16* Y = (bf16*)(ws + WS_Y); bf16* HF = (bf16*)(ws + WS_HF);
    const float* mod = (const float*)(ws + WS_MOD); const float* rc = (const float*)(ws + WS_ROPE); const float* rs = rc + 1024;
    volatile LAS unsigned* MISC = (volatile LAS unsigned*)((LAS unsigned char*)lds_raw + RING_BYTES + 320);
    if (threadIdx.x < 32) MISC[threadIdx.x] = 0u;
    __syncthreads();
    XcdBarrier bar = xcd_barrier_post((unsigned*)(ws + 4096 * 4), MISC + 8);
    prologue(F, args);
    grid.sync();
    LAS float* ropel = (LAS float*)((LAS unsigned char*)lds_raw + RING_BYTES + 1024);
    for (int i = threadIdx.x; i < 2048; i += NTHR) ropel[i] = rc[i];
    __syncthreads();
    for (int l = 0; l < DEPTH; ++l) {
        const bool last = l == DEPTH - 1;
        const int Mpost = last ? MLAT : MALL;
        const float* modl = mod + (size_t)l * 5 * 6144;
        const unsigned char* wl = ws + WS_W + (size_t)l * WL_STRIDE;
        MKFRAME();
        if (l == 0) norm_phase(F, args.in[0], args.in[2], X, H, args.in[6], modl, 0, MALL);
        else norm_phase(F, X, X + (size_t)MLAT * DM, nullptr, H, args.in[6] + l * DM, modl, 0, MALL);
        xcd_barrier(bar);
        { pg8::Gemm g{H, (const bf16*)(wl + WO_IN), MALL, INC, DM}; pg8::StaticOrder S; S.init(MALL, INC, F.G, F.bid);
          pg8::EpiInProj E{Qb, Kb, VTb, SG, args.in[9] + l * 64, args.in[10] + l * 64, ropel, nullptr, nullptr};
          pg8::gemm_phase<pg8::EpiInProj, pg8::StaticOrder, true, true>(F.lds, g, S, E); }
        xcd_barrier(bar);
        MKFRAME();
        attn_phase(F, Qb, Kb, VTb, Y, args.in[11] + l * 8, last ? 1024 : 1088);
        xcd_barrier(bar);
        { pg8::Gemm g{Y, (const bf16*)(wl + WO_P), MLAT, DM, 512}; pg8::PairedOrder S; S.base.init(MLAT, DM, F.G, F.bid); S.dM = NPAN_ALL; S.dN = 4;
          pg8::EpiMerge E{SG, H};
          pg8::gemm_phase<pg8::EpiMerge, pg8::PairedOrder, true, true>(F.lds, g, S, E); }
        if (!last) { MKFRAME(); ctx_merge_tiles(F, Y, (const bf16*)(wl + WO_P), SG, H); }
        xcd_barrier(bar);
        { pg8::Gemm g{H, (const bf16*)(wl + WO_O), MLAT, DM, DM}; pg8::StaticOrder S; S.init(MLAT, DM, F.G, F.bid);
          pg8::EpiResid E{modl + 2 * 1024, X, nullptr, nullptr, nullptr, nullptr};
          pg8::gemm_phase<pg8::EpiResid, pg8::StaticOrder, true, true>(F.lds, g, S, E); }
        if (!last) { MKFRAME(); ctx_resid_tiles(F, H, DM, (const bf16*)(wl + WO_O), modl + 4 * 6144 + 2 * 1024, X); }
        xcd_barrier(bar);
        MKFRAME();
        norm_phase(F, X, X + (size_t)MLAT * DM, nullptr, H, args.in[7] + l * DM, modl, 3, Mpost);
        xcd_barrier(bar);
        { pg8::Gemm g{H, (const bf16*)(wl + WO_GU), Mpost, NGU, DM}; pg8::StaticOrder S; S.init(Mpost, NGU, F.G, F.bid);
          pg8::EpiSwiGLU E{HF};
          pg8::gemm_phase<pg8::EpiSwiGLU, pg8::StaticOrder, true, true>(F.lds, g, S, E); }
        xcd_barrier(bar);
        { pg8::Gemm g{HF, (const bf16*)(wl + WO_D), MLAT, DM, DFF}; pg8::StaticOrder S; S.init(MLAT, DM, F.G, F.bid);
          pg8::EpiResid E{modl + 5 * 1024, X, nullptr, nullptr, nullptr, nullptr};
          pg8::gemm_phase<pg8::EpiResid, pg8::StaticOrder, true, true>(F.lds, g, S, E); }
        if (!last) { MKFRAME(); ctx_resid_tiles(F, HF, DFF, (const bf16*)(wl + WO_D), modl + 4 * 6144 + 5 * 1024, X); }
        xcd_barrier(bar);
    }
    MKFRAME();
    final_norm(F, X, args.out, args.in[18]);
}

extern "C" void kernel_launch(void* const* d_in, const int* in_sizes, int n_in, void* d_out, int out_size, void* d_ws, size_t ws_size, hipStream_t stream) {
    static int grid = 0;
    if (grid == 0) {
        if (n_in != 19 || ws_size < WS_END) { fprintf(stderr, "kernel_launch: need 19 inputs and >= %zu bytes of workspace (got %d, %zu)\n", (size_t)WS_END, n_in, ws_size); grid = -1; return; }
        int dev = 0, cus = 0, per_cu = 0;
        hipGetDevice(&dev); hipDeviceGetAttribute(&cus, hipDeviceAttributeMultiprocessorCount, dev);
        hipFuncSetAttribute((const void*)fwd_megakernel, hipFuncAttributeMaxDynamicSharedMemorySize, LDS_BYTES);
        if (hipOccupancyMaxActiveBlocksPerMultiprocessor(&per_cu, (const void*)fwd_megakernel, NTHR, LDS_BYTES) != hipSuccess || per_cu < 1) { fprintf(stderr, "kernel_launch: occupancy query says %d\n", per_cu); per_cu = 1; }
        (void)hipGetLastError();
        grid = cus * per_cu;
    }
    if (grid < 0) return;
    if (hipMemsetAsync(d_ws, 0, 65536, stream) != hipSuccess) { fprintf(stderr, "kernel_launch: memset of the barrier words failed\n"); return; }
    Args a{};
    for (int i = 0; i < 19; ++i) a.in[i] = (const float*)d_in[i];
    a.out = (float*)d_out; a.ws = (unsigned char*)d_ws;
    void* kargs[] = {&a};
    hipError_t e = hipLaunchCooperativeKernel((const void*)fwd_megakernel, dim3(grid), dim3(NTHR), kargs, LDS_BYTES, stream);
    if (e != hipSuccess) fprintf(stderr, "cooperative launch failed: %s (grid %d)\n", hipGetErrorString(e), grid);
}
```

```cpp
#include <hip/hip_runtime.h>
#include <hip/hip_cooperative_groups.h>
#include <cstdio>
#include <cstdint>
namespace cg = cooperative_groups;

constexpr int DM = 1024, NB = 4, SEQ = 4096, DEPTH = 4, CTXL = 256, SALL = SEQ + CTXL, MLAT = NB * SEQ, MCTX = NB * CTXL, MALL = MLAT + MCTX;
constexpr int INC = 3584, DFF = 2816, NGU = 2 * DFF, NPAN_ALL = MALL / 256;
constexpr float NORM_EPS = 1e-6f;
constexpr float QSCALE = 0.125f * 1.4426950408889634f;
constexpr float LOG2E = 1.4426950408889634f;
namespace pg8 {
#define PG8_LAS __attribute__((address_space(3)))
typedef unsigned short bf16_t;
typedef short bf16x8 __attribute__((ext_vector_type(8)));
typedef float f32x4 __attribute__((ext_vector_type(4)));
typedef unsigned u32x4 __attribute__((ext_vector_type(4)));
constexpr int BM = 256, BK = 64, HALF = 128, HTB = HALF * BK * 2  , STAGE_BYTES = 8 * HTB, NXCD = 8, WGM = 8;

__host__ __device__ __forceinline__ int lds_byte(int r, int c) { const int st = (r >> 4) * 2 + (c >> 5), rr = r & 15, cc = c & 31, ob = rr * 64 + cc * 2; return st * 1024 + (ob ^ (((ob >> 9) & 1) << 5)); }
__host__ __device__ __forceinline__ void stage_rc(int b, int& R, int& C) { const int st = b / 1024, sb = b % 1024, swz = sb ^ (((sb >> 9) & 1) << 5); R = (st >> 1) * 16 + swz / 64; C = (st & 1) * 32 + (swz % 64) / 2; }
__host__ __device__ __forceinline__ int perm32(int rho) { const int n = rho >> 4, i = rho & 15; return 8 * (i >> 2) + 4 * n + (i & 3); }

struct Unit { int pm, pn; };
struct Gemm { const bf16_t* A; const bf16_t* Bt; int M, N, K; };

struct StaticOrder {
    int nM, nN, nwg, G, c;
    __host__ __device__ void init(int M, int N, int G_, int c_) { nM = M / BM; nN = N / BM; nwg = nM * nN; G = G_; c = c_; }
    __host__ __device__ bool next(int i, Unit& u) const {
        const long L = (long)i * G + c; if (L >= nwg) return false;
        int wgid = (int)L; { const int q = nwg / NXCD, r = nwg % NXCD, xcd = wgid % NXCD, off = wgid / NXCD; wgid = (xcd < r ? xcd * (q + 1) : r * (q + 1) + (xcd - r) * q) + off; }
        const int nig = WGM * nN, gid = wgid / nig, fm = gid * WGM, gsz = (nM - fm) < WGM ? (nM - fm) : WGM;
        u.pm = fm + ((wgid % nig) % gsz); u.pn = (wgid % nig) / gsz; return true;
    }
    __device__ __forceinline__ void a_ready(const Unit&) const {}
    __device__ __forceinline__ void done(const Unit&) const {}
};

__device__ __forceinline__ unsigned cvt_pk_bf16(float lo, float hi) { unsigned r; asm volatile("v_cvt_pk_bf16_f32 %0, %1, %2" : "=v"(r) : "v"(lo), "v"(hi)); return r; }
typedef float f32x2 __attribute__((ext_vector_type(2)));
typedef unsigned u32x2 __attribute__((ext_vector_type(2)));
__device__ __forceinline__ u32x2 pack4(f32x4 v) { u32x2 w; w.x = cvt_pk_bf16(v[0], v[1]); w.y = cvt_pk_bf16(v[2], v[3]); return w; }
__device__ __forceinline__ f32x4 unpack4(u32x2 w) { f32x4 v; v[0] = __uint_as_float(w.x << 16); v[1] = __uint_as_float(w.x & 0xffff0000u); v[2] = __uint_as_float(w.y << 16); v[3] = __uint_as_float(w.y & 0xffff0000u); return v; }
__device__ __forceinline__ float sigmoidf_(float v) { return 1.0f / (1.0f + __expf(-v)); }

struct EpiInProj {
    static constexpr bool PERM = false, AFTER_DRAIN = false;
    static __device__ __forceinline__ bool keep(const Unit&) { return false; }
    bf16_t *Q, *K, *VT, *SG; const float *qg, *kg; const PG8_LAS float* ropel; const float* rowss; const float* bias;
    __device__ __forceinline__ void operator()(f32x4 (&acc)[2][2][4][2], const Unit& u, int wr, int wc, int fr, int fq) const {
        const int pn = u.pn; const int vb = u.pm < (MLAT / 256) ? (u.pm >> 4) : 4;
        const int row0 = u.pm * 256 + wr * 64 + fr;
        float rstd[2][4]; f32x4 bv[2][2];
#pragma unroll
        for (int ai = 0; ai < 2; ++ai)
#pragma unroll
            for (int m = 0; m < 4; ++m) rstd[ai][m] = rowss ? rowss[row0 + ai * 128 + m * 16] : 0.f;
#pragma unroll
        for (int bj = 0; bj < 2; ++bj)
#pragma unroll
            for (int n = 0; n < 2; ++n) bv[bj][n] = rowss ? *(const f32x4*)(bias + vb * INC + pn * 256 + 128 * bj + 32 * wc + 16 * n + 4 * fq) : (f32x4){0.f, 0.f, 0.f, 0.f};
        const int br = (pn >= 6) ? ((pn - 6) >> 2) : (pn >= 3 ? 1 : 0), pl = pn - 3 * br;
        const bool isQ = pl < 2, isV = (!isQ) && wc >= 2, donorm = (pn < 6) && (br == 1) && !isV;
        const float* gvec = isQ ? qg : kg;
        f32x4 gl[2][2];
#pragma unroll
        for (int bj = 0; bj < 2; ++bj)
#pragma unroll
            for (int n = 0; n < 2; ++n) gl[bj][n] = donorm ? *(const f32x4*)(gvec + 32 * bj + 16 * n + 4 * fq) : (f32x4){1.f, 1.f, 1.f, 1.f};
#pragma unroll
        for (int ai = 0; ai < 2; ++ai)
#pragma unroll
            for (int m = 0; m < 4; ++m) rstd[ai][m] = rowss ? 1.0f / sqrtf(rstd[ai][m] * (1.0f / 1024.0f) + NORM_EPS) : 1.0f;
        if (pn >= 6) {
            const int cbase = ((pn - 6) & 3) * 256 + wc * 64 + 4 * fq;
#pragma unroll
            for (int ai = 0; ai < 2; ++ai)
#pragma unroll
                for (int m = 0; m < 4; ++m) { const int row = row0 + ai * 128 + m * 16; bf16_t* dst = SG + ((size_t)br * MALL + row) * 1024 + cbase;
#pragma unroll
                    for (int bj = 0; bj < 2; ++bj)
#pragma unroll
                        for (int n = 0; n < 2; ++n) { f32x4 v = acc[ai][bj][m][n] * rstd[ai][m] + bv[bj][n];
                            v[0] = sigmoidf_(v[0]); v[1] = sigmoidf_(v[1]); v[2] = sigmoidf_(v[2]); v[3] = sigmoidf_(v[3]);
                            *(u32x2*)(dst + 32 * bj + 16 * n) = pack4(v); } }
            return;
        }
        const int head = isQ ? pl * 4 + wc : (wc & 1);
#pragma unroll
        for (int ai = 0; ai < 2; ++ai)
#pragma unroll
            for (int m = 0; m < 4; ++m) {
                const int row = row0 + ai * 128 + m * 16;
                const bool isctx = row >= MLAT;
                const int b = isctx ? (row - MLAT) >> 8 : row >> 12;
                const int sall = isctx ? SEQ + ((row - MLAT) & 255) : row & (SEQ - 1);
                f32x4 v[2][2];
#pragma unroll
                for (int bj = 0; bj < 2; ++bj)
#pragma unroll
                    for (int n = 0; n < 2; ++n) v[bj][n] = acc[ai][bj][m][n] * rstd[ai][m] + bv[bj][n];
                if (donorm) {
                    float ss = 0.f;
#pragma unroll
                    for (int bj = 0; bj < 2; ++bj)
#pragma unroll
                        for (int n = 0; n < 2; ++n) ss += (v[bj][n][0] * v[bj][n][0] + v[bj][n][1] * v[bj][n][1]) + (v[bj][n][2] * v[bj][n][2] + v[bj][n][3] * v[bj][n][3]);
                    ss += __shfl_xor(ss, 16); ss += __shfl_xor(ss, 32);
                    const float rs_ = 1.0f / sqrtf(ss * (1.0f / 64.0f) + NORM_EPS);
#pragma unroll
                    for (int bj = 0; bj < 2; ++bj)
#pragma unroll
                        for (int n = 0; n < 2; ++n) v[bj][n] = (v[bj][n] * rs_) * gl[bj][n];
                }
                if (!isV && !isctx) {
#pragma unroll
                    for (int bj = 0; bj < 2; ++bj) { const int pos = bj ? (sall & 63) : (sall >> 6);
                        const f32x4 c = *(const PG8_LAS f32x4*)(ropel + pos * 16 + 4 * fq), s = *(const PG8_LAS f32x4*)(ropel + 1024 + pos * 16 + 4 * fq);
                        const f32x4 x1 = v[bj][0], x2 = v[bj][1]; v[bj][0] = x1 * c - x2 * s; v[bj][1] = x2 * c + x1 * s; }
                }
                if (isQ) { bf16_t* dst = Q + ((size_t)((br * NB + b) * 8 + head) * SALL + sall) * 64 + 4 * fq;
#pragma unroll
                    for (int bj = 0; bj < 2; ++bj)
#pragma unroll
                        for (int n = 0; n < 2; ++n) *(u32x2*)(dst + 32 * bj + 16 * n) = pack4(v[bj][n] * QSCALE);
                } else if (!isV) { bf16_t* dst = K + ((size_t)((br * NB + b) * 2 + head) * SALL + sall) * 64 + 4 * fq;
#pragma unroll
                    for (int bj = 0; bj < 2; ++bj)
#pragma unroll
                        for (int n = 0; n < 2; ++n) *(u32x2*)(dst + 32 * bj + 16 * n) = pack4(v[bj][n]);
                } else { bf16_t* dst = VT + ((size_t)((br * NB + b) * 2 + head) * 64 + 4 * fq) * SALL + sall;
#pragma unroll
                    for (int bj = 0; bj < 2; ++bj)
#pragma unroll
                        for (int n = 0; n < 2; ++n) { const u32x2 w = pack4(v[bj][n]); bf16_t* d2 = dst + (size_t)(32 * bj + 16 * n) * SALL;
                            d2[0] = (bf16_t)(w.x & 0xffffu); d2[SALL] = (bf16_t)(w.x >> 16); d2[2 * SALL] = (bf16_t)(w.y & 0xffffu); d2[3 * SALL] = (bf16_t)(w.y >> 16); }
                }
            }
    }
};
struct EpiMerge {
    static constexpr bool PERM = false, AFTER_DRAIN = false;
    static __device__ __forceinline__ bool keep(const Unit& u) { return u.pn < 4; }
    const bf16_t* SG; bf16_t* Mb;
    __device__ __forceinline__ void operator()(f32x4 (&acc)[2][2][4][2], const Unit& u, int wr, int wc, int fr, int fq) const {
        const bool second = u.pn >= 4; const int pn = u.pn & 3, pm = second ? u.pm - NPAN_ALL : u.pm;
        const size_t row0 = (size_t)(pm * 256 + wr * 64 + fr);
#pragma unroll
        for (int bj = 0; bj < 2; ++bj)
#pragma unroll
          for (int n = 0; n < 2; ++n) {
            const int col = pn * 256 + 128 * bj + 32 * wc + 16 * n + 4 * fq;
            u32x2 sbw[2][4], saw[2][4];
#pragma unroll
            for (int ai = 0; ai < 2; ++ai)
#pragma unroll
                for (int m = 0; m < 4; ++m) { const size_t off = (row0 + ai * 128 + m * 16) * 1024 + col;
                    sbw[ai][m] = *(const u32x2*)(SG + (size_t)MALL * 1024 + off); saw[ai][m] = second ? sbw[ai][m] : *(const u32x2*)(SG + off); }
#pragma unroll
            for (int ai = 0; ai < 2; ++ai)
#pragma unroll
                for (int m = 0; m < 4; ++m) { const size_t off = (row0 + ai * 128 + m * 16) * 1024 + col;
                    const f32x4 sb = unpack4(sbw[ai][m]);
                    if (!second) { const f32x4 sa = unpack4(saw[ai][m]); acc[ai][bj][m][n] = acc[ai][bj][m][n] * (sa / sb); }
                    else *(u32x2*)(Mb + off) = pack4(acc[ai][bj][m][n] * sb); }
          }
    }
};
struct EpiResid {
    static constexpr bool PERM = false, AFTER_DRAIN = false;
    static __device__ __forceinline__ bool keep(const Unit&) { return false; }
    const float* gate; float* X;
    bf16_t* XG; float* rowss; const float* ng; const float* nsc;
    __device__ __forceinline__ void operator()(f32x4 (&acc)[2][2][4][2], const Unit& u, int wr, int wc, int fr, int fq) const {
        const int v = u.pm < (MLAT / 256) ? (u.pm >> 4) : 4;
        const size_t row0 = (size_t)(u.pm * 256 + wr * 64 + fr);
        float ssq[2][4];
#pragma unroll
        for (int ai = 0; ai < 2; ++ai)
#pragma unroll
            for (int m = 0; m < 4; ++m) ssq[ai][m] = 0.f;
#pragma unroll
        for (int bj = 0; bj < 2; ++bj)
#pragma unroll
          for (int n = 0; n < 2; ++n) {
            const int col = u.pn * 256 + 128 * bj + 32 * wc + 16 * n + 4 * fq;
            const f32x4 g = *(const f32x4*)(gate + v * 6144 + col);
            f32x4 G = {0.f, 0.f, 0.f, 0.f};
            if (XG) G = *(const f32x4*)(ng + col) * (*(const f32x4*)(nsc + v * 6144 + col) + 1.0f);
            f32x4 xv[2][4];
#pragma unroll
            for (int ai = 0; ai < 2; ++ai)
#pragma unroll
                for (int m = 0; m < 4; ++m) xv[ai][m] = *(const f32x4*)(X + (row0 + ai * 128 + m * 16) * 1024 + col);
#pragma unroll
            for (int ai = 0; ai < 2; ++ai)
#pragma unroll
                for (int m = 0; m < 4; ++m) { const size_t off = (row0 + ai * 128 + m * 16) * 1024 + col;
                    const f32x4 xn = xv[ai][m] + g * acc[ai][bj][m][n]; *(f32x4*)(X + off) = xn;
                    if (XG) { ssq[ai][m] += (xn[0] * xn[0] + xn[1] * xn[1]) + (xn[2] * xn[2] + xn[3] * xn[3]); *(u32x2*)(XG + off) = pack4(xn * G); } }
          }
        if (XG) {
#pragma unroll
            for (int ai = 0; ai < 2; ++ai)
#pragma unroll
                for (int m = 0; m < 4; ++m) { float q = ssq[ai][m]; q += __shfl_xor(q, 16); q += __shfl_xor(q, 32);
                    if (fq == 0) atomicAdd(rowss + row0 + ai * 128 + m * 16, q); }
        }
    }
};
struct EpiSwiGLU {
    static constexpr bool PERM = false, AFTER_DRAIN = false;
    static __device__ __forceinline__ bool keep(const Unit&) { return false; }
    bf16_t* Hf;
    __device__ __forceinline__ void operator()(f32x4 (&acc)[2][2][4][2], const Unit& u, int wr, int wc, int fr, int fq) const {
#pragma unroll
        for (int ai = 0; ai < 2; ++ai)
#pragma unroll
            for (int m = 0; m < 4; ++m) { bf16_t* dst = Hf + (size_t)(u.pm * 256 + ai * 128 + wr * 64 + m * 16 + fr) * DFF + 128 * u.pn + 16 * wc + 4 * fq;
#pragma unroll
                for (int bj = 0; bj < 2; ++bj) { const f32x4 g = acc[ai][bj][m][0], up = acc[ai][bj][m][1]; f32x4 h;
#pragma unroll
                    for (int j = 0; j < 4; ++j) h[j] = g[j] * sigmoidf_(g[j]) * up[j];
                    *(u32x2*)(dst + 64 * bj) = pack4(h); } }
    }
};
struct PairedOrder {
    StaticOrder base; int dM, dN;
    __device__ bool next(int i, Unit& u) const { if (!base.next(i >> 1, u)) return false; if (i & 1) { u.pm += dM; u.pn += dN; } return true; }
    __device__ __forceinline__ void a_ready(const Unit&) const {}
    __device__ __forceinline__ void done(const Unit&) const {}
};
template <class Epi, class Sched, bool ALIGN_EPI = false, bool SP2 = false>
__device__ __forceinline__ void gemm_phase(PG8_LAS unsigned char* lds, const Gemm g, const Sched& S, const Epi& E) {
    int tid_ = threadIdx.x; asm volatile("" : "+v"(tid_));
    const int tid = tid_, wid = __builtin_amdgcn_readfirstlane(tid >> 6), lane = tid & 63, wr = wid >> 2, wc = wid & 3, fr = lane & 15, fq = lane >> 4;
    const int K = g.K, nt = K / BK;
    unsigned voffA[2], voffB[2];
#pragma unroll
    for (int i = 0; i < 2; ++i) { int R, C; stage_rc(tid * 16 + i * 8192, R, C); const int Rb = Epi::PERM ? ((R & ~31) + perm32(R & 31)) : R;
        voffA[i] = (unsigned)(R * K + C) * 2u; voffB[i] = (unsigned)(Rb * K + C) * 2u; }
    const size_t kstep = (size_t)(BK * 2);
    const size_t hstep = (size_t)HALF * K * 2;
    const size_t tstep = 2 * hstep;
    const unsigned ldsw = (unsigned)wid * 1024u;
    const int aoff = lds_byte(wr * 64 + fr, fq * 8), boff = lds_byte(wc * 32 + fr, fq * 8);
#define PG8_SA(b, h) (((b) * 2 + (h)) * HTB)
#define PG8_SB(b, h) ((4 + (b) * 2 + (h)) * HTB)
#define PG8_STAGE(bufoff, gbase, voff) do { _Pragma("unroll") for (int _i = 0; _i < 2; ++_i) \
        __builtin_amdgcn_global_load_lds((const unsigned*)((const char*)(gbase) + (voff)[_i]), (PG8_LAS unsigned*)(lds + (bufoff) + ldsw + _i * 8192), 16, 0, 0); } while (0)
#define PG8_LDA(dst, b, h) do { _Pragma("unroll") for (int m = 0; m < 4; ++m) _Pragma("unroll") for (int k = 0; k < 2; ++k) dst[m][k] = *(const PG8_LAS bf16x8*)(lds + PG8_SA(b, h) + aoff + m * 2048 + k * 1024); } while (0)
#define PG8_LDB(dst, b, h) do { _Pragma("unroll") for (int n = 0; n < 2; ++n) _Pragma("unroll") for (int k = 0; k < 2; ++k) dst[n][k] = *(const PG8_LAS bf16x8*)(lds + PG8_SB(b, h) + boff + n * 2048 + k * 1024); } while (0)
#define PG8_MMA(ai, bj, At, Bt) do { __builtin_amdgcn_s_setprio(1); _Pragma("unroll") for (int m = 0; m < 4; ++m) _Pragma("unroll") for (int n = 0; n < 2; ++n) _Pragma("unroll") for (int k = 0; k < 2; ++k) \
        acc[ai][bj][m][n] = __builtin_amdgcn_mfma_f32_16x16x32_bf16(Bt[n][k], At[m][k], acc[ai][bj][m][n], 0, 0, 0); __builtin_amdgcn_s_setprio(0); } while (0)
#define PG8_WAIT_V(n) asm volatile("s_waitcnt vmcnt(" #n ")" ::: "memory")
#define PG8_WAIT_L(n) asm volatile("s_waitcnt lgkmcnt(" #n ")" ::: "memory")
#define PG8_BAR __builtin_amdgcn_s_barrier()
#define PG8_SCHED __builtin_amdgcn_sched_barrier(0)
    Unit cur, nxt; int ui = 0;
    if (!S.next(0, cur)) return;
    f32x4 acc[2][2][4][2];
#pragma unroll
    for (int a = 0; a < 2; ++a)
#pragma unroll
        for (int b = 0; b < 2; ++b)
#pragma unroll
            for (int m = 0; m < 4; ++m)
#pragma unroll
                for (int n = 0; n < 2; ++n) acc[a][b][m][n] = (f32x4){0.f, 0.f, 0.f, 0.f};
    bf16x8 At[4][2], B0[2][2], B1[2][2];
    const char* cA = (const char*)g.A + (size_t)cur.pm * tstep; const char* cB = (const char*)g.Bt + (size_t)cur.pn * tstep;
    S.a_ready(cur);
    if constexpr (SP2) {
        PG8_STAGE(PG8_SB(0, 0), cB, voffB); PG8_STAGE(PG8_SB(0, 1), cB + hstep, voffB); PG8_STAGE(PG8_SA(0, 0), cA, voffA); PG8_STAGE(PG8_SA(0, 1), cA + hstep, voffA);
        if (wr == 1) PG8_BAR;
        PG8_WAIT_V(2); PG8_BAR;
        PG8_STAGE(PG8_SB(1, 0), cB + kstep, voffB); PG8_STAGE(PG8_SA(1, 0), cA + kstep, voffA); PG8_STAGE(PG8_SB(1, 1), cB + hstep + kstep, voffB);
        PG8_WAIT_V(6); PG8_BAR;
    } else {
        PG8_STAGE(PG8_SB(0, 0), cB, voffB); PG8_STAGE(PG8_SA(0, 0), cA, voffA); PG8_STAGE(PG8_SB(0, 1), cB + hstep, voffB); PG8_STAGE(PG8_SA(0, 1), cA + hstep, voffA);
        if (wr == 1) PG8_BAR;
        PG8_WAIT_V(4); PG8_BAR;
        PG8_STAGE(PG8_SB(1, 0), cB + kstep, voffB); PG8_STAGE(PG8_SA(1, 0), cA + kstep, voffA); PG8_STAGE(PG8_SB(1, 1), cB + hstep + kstep, voffB);
        PG8_WAIT_V(6); PG8_BAR;
    }
    for (;;) {
        const bool has_next = S.next(ui + 1, nxt);
        const char* nA = has_next ? (const char*)g.A + (size_t)nxt.pm * tstep : cA; const char* nB = has_next ? (const char*)g.Bt + (size_t)nxt.pn * tstep : cB;
        for (int t = 0; t < nt; t += 2) {
            const bool last = (t == nt - 2);
            const char* a1 = cA + (size_t)(t + 1) * kstep;
            const char* a2 = last ? nA : cA + (size_t)(t + 2) * kstep; const char* b2 = last ? nB : cB + (size_t)(t + 2) * kstep;
            const char* a3 = a2 + kstep; const char* b3 = b2 + kstep;
            if (last && has_next) S.a_ready(nxt);
            if constexpr (SP2) {
            PG8_LDB(B0, 0, 0); PG8_LDB(B1, 0, 1); PG8_SCHED; PG8_LDA(At, 0, 0); PG8_STAGE(PG8_SA(1, 1), a1 + hstep, voffA);
            PG8_WAIT_V(8); PG8_WAIT_L(0); PG8_BAR; PG8_MMA(0, 0, At, B0); PG8_MMA(0, 1, At, B1); PG8_BAR; PG8_SCHED;
            PG8_LDA(At, 0, 1); PG8_STAGE(PG8_SB(0, 0), b2, voffB); PG8_STAGE(PG8_SB(0, 1), b2 + hstep, voffB); PG8_STAGE(PG8_SA(0, 0), a2, voffA);
            PG8_WAIT_V(8); PG8_WAIT_L(0); PG8_BAR; PG8_MMA(1, 0, At, B0); PG8_MMA(1, 1, At, B1); PG8_BAR; PG8_SCHED;
            PG8_LDB(B0, 1, 0); PG8_LDB(B1, 1, 1); PG8_SCHED; PG8_LDA(At, 1, 0); PG8_STAGE(PG8_SA(0, 1), a2 + hstep, voffA);
            PG8_WAIT_V(8); PG8_WAIT_L(0); PG8_BAR; PG8_MMA(0, 0, At, B0); PG8_MMA(0, 1, At, B1); PG8_BAR; PG8_SCHED;
            PG8_LDA(At, 1, 1); PG8_STAGE(PG8_SB(1, 0), b3, voffB); PG8_STAGE(PG8_SB(1, 1), b3 + hstep, voffB); PG8_STAGE(PG8_SA(1, 0), a3, voffA);
            PG8_WAIT_V(8); PG8_WAIT_L(0); PG8_BAR; PG8_MMA(1, 0, At, B0); PG8_MMA(1, 1, At, B1); PG8_BAR; PG8_SCHED;
            } else {
            PG8_LDB(B0, 0, 0); PG8_SCHED; PG8_LDA(At, 0, 0); PG8_STAGE(PG8_SA(1, 1), a1 + hstep, voffA);
            PG8_WAIT_L(8); PG8_BAR; PG8_WAIT_L(0); PG8_MMA(0, 0, At, B0); PG8_BAR; PG8_SCHED;
            PG8_LDB(B1, 0, 1); PG8_STAGE(PG8_SB(0, 0), b2, voffB);
            PG8_BAR; PG8_WAIT_L(0); PG8_MMA(0, 1, At, B1); PG8_BAR;
            PG8_LDA(At, 0, 1); PG8_STAGE(PG8_SA(0, 0), a2, voffA);
            PG8_BAR; PG8_WAIT_L(0); PG8_MMA(1, 0, At, B0); PG8_BAR; PG8_SCHED;
            PG8_STAGE(PG8_SB(0, 1), b2 + hstep, voffB);
            PG8_WAIT_V(6); PG8_BAR; PG8_MMA(1, 1, At, B1); PG8_BAR;
            PG8_LDB(B0, 1, 0); PG8_SCHED; PG8_LDA(At, 1, 0); PG8_STAGE(PG8_SA(0, 1), a2 + hstep, voffA);
            PG8_WAIT_L(8); PG8_BAR; PG8_WAIT_L(0); PG8_MMA(0, 0, At, B0); PG8_BAR; PG8_SCHED;
            PG8_LDB(B1, 1, 1); PG8_STAGE(PG8_SB(1, 0), b3, voffB);
            PG8_BAR; PG8_WAIT_L(0); PG8_MMA(0, 1, At, B1); PG8_BAR;
            PG8_LDA(At, 1, 1); PG8_STAGE(PG8_SA(1, 0), a3, voffA);
            PG8_BAR; PG8_WAIT_L(0); PG8_MMA(1, 0, At, B0); PG8_BAR; PG8_SCHED;
            PG8_STAGE(PG8_SB(1, 1), b3 + hstep, voffB);
            PG8_WAIT_V(6); PG8_BAR; PG8_MMA(1, 1, At, B1); PG8_BAR;
            }
        }
        if constexpr (ALIGN_EPI) { if (wr == 0) PG8_BAR; }
        if constexpr (!Epi::AFTER_DRAIN) { E(acc, cur, wr, wc, fr, fq); S.done(cur); }
        if (!has_next) break;
        if (!Epi::keep(cur))
#pragma unroll
        for (int a = 0; a < 2; ++a)
#pragma unroll
            for (int b = 0; b < 2; ++b)
#pragma unroll
                for (int m = 0; m < 4; ++m)
#pragma unroll
                    for (int n = 0; n < 2; ++n) acc[a][b][m][n] = (f32x4){0.f, 0.f, 0.f, 0.f};
        cur = nxt; cA = nA; cB = nB; ++ui;
        if constexpr (ALIGN_EPI) { if (wr == 1) PG8_BAR; }
    }
    PG8_WAIT_V(0);
    if constexpr (!ALIGN_EPI) { if (wr == 0) PG8_BAR; }
    PG8_BAR;
    if constexpr (Epi::AFTER_DRAIN) { E.fused(acc, cur, wr, wc, fr, fq, lds, wid, lane); S.done(cur); }
#undef PG8_SA
#undef PG8_SB
#undef PG8_STAGE
#undef PG8_LDA
#undef PG8_LDB
#undef PG8_MMA
#undef PG8_WAIT_V
#undef PG8_WAIT_L
#undef PG8_BAR
#undef PG8_SCHED
}
}
#define GAS __attribute__((address_space(1)))
#define LAS __attribute__((address_space(3)))
typedef unsigned short bf16;
typedef unsigned v4u __attribute__((ext_vector_type(4)));
typedef unsigned v2u __attribute__((ext_vector_type(2)));
typedef float f32x4 __attribute__((ext_vector_type(4)));
typedef float f32x16 __attribute__((ext_vector_type(16)));
typedef short bf16x8 __attribute__((ext_vector_type(8)));
typedef short s16x4 __attribute__((ext_vector_type(4)));
constexpr int NWAVES = 8, NTHR = 512;
constexpr int RING_BYTES = 131072, LDS_BYTES = 147456;
constexpr size_t MiB = 1u << 20;
constexpr size_t WS_MOD = 1 * MiB, WS_ROPE = 1 * MiB + 512 * 1024, WS_W = 2 * MiB, WL_STRIDE = 27 * MiB + 512 * 1024;
constexpr size_t WO_IN = 0, WO_P = 7 * MiB, WO_O = 9 * MiB, WO_GU = 11 * MiB, WO_D = 22 * MiB;
constexpr size_t WS_X = 112 * MiB, WS_H = 180 * MiB, WS_Q = 214 * MiB, WS_K = 248 * MiB, WS_VT = 256 * MiB + 512 * 1024, WS_SG = 265 * MiB, WS_Y = 333 * MiB, WS_HF = 265 * MiB, WS_END = 367 * MiB;
static_assert(WS_W + DEPTH * WL_STRIDE <= WS_X && WS_X + (size_t)MALL * DM * 4 <= WS_H && WS_H + (size_t)MALL * DM * 2 <= WS_Q && WS_Q + (size_t)2 * NB * 8 * SALL * 64 * 2 <= WS_K, "ws map 1");
static_assert(WS_K + (size_t)2 * NB * 2 * SALL * 64 * 2 <= WS_VT && WS_VT + (size_t)2 * NB * 2 * SALL * 64 * 2 <= WS_SG && WS_SG + (size_t)2 * MALL * DM * 2 <= WS_Y && WS_Y + (size_t)2 * MALL * 512 * 2 <= WS_END && WS_HF + (size_t)MALL * DFF * 2 <= WS_END, "ws map 2");

struct Args { const float* in[19]; float* out; unsigned char* ws; };
struct Frame { LAS unsigned char* lds; int tid, lane, wave, G, bid; };

__device__ __forceinline__ unsigned f2bf(float f) { unsigned u = __builtin_bit_cast(unsigned, f); return (u + 0x7fffu + ((u >> 16) & 1u)) >> 16; }
__device__ __forceinline__ unsigned pk2(float lo, float hi) { return f2bf(lo) | (f2bf(hi) << 16); }
__device__ __forceinline__ float wave_sum(float v) {
#pragma unroll
    for (int o = 1; o < 64; o <<= 1) v += __shfl_xor(v, o);
    return v;
}
__device__ __forceinline__ int wrow_map(int mode, int n) {
    if (mode == 1) return ((n >> 8) << 8) + (((n & 63) >> 5) << 7) + (((n >> 6) & 3) << 5) + (n & 31);
    if (mode == 2) return ((n >> 4) << 5) + (n & 15);
    if (mode == 3) return ((n >> 4) << 5) + 16 + (n & 15);
    return n;
}
__device__ __forceinline__ void transpose_item(const float* W, int K, int N, bf16* WT, int row_off, int mode, LAS float* scr, int item, int lane) {
    const int nblk = N / 32, kb = item / nblk, nb = item % nblk, k0 = 64 * kb, n0 = 32 * nb;
#pragma unroll 8
    for (int i = 0; i < 32; ++i) { const int kk = 2 * i + (lane >> 5); scr[kk * 33 + (lane & 31)] = W[(size_t)(k0 + kk) * N + n0 + (lane & 31)]; }
    asm volatile("s_waitcnt lgkmcnt(0)" ::: "memory");
    const int c = lane & 7;
#pragma unroll
    for (int j = 0; j < 4; ++j) { const int n = (lane >> 3) + 8 * j; const LAS float* s = scr + (8 * c) * 33 + n;
        v4u o; o.x = pk2(s[0 * 33], s[1 * 33]); o.y = pk2(s[2 * 33], s[3 * 33]); o.z = pk2(s[4 * 33], s[5 * 33]); o.w = pk2(s[6 * 33], s[7 * 33]);
        *(v4u*)(WT + (size_t)(row_off + wrow_map(mode, n0 + n)) * K + k0 + 8 * c) = o; }
    asm volatile("s_waitcnt lgkmcnt(0)" ::: "memory");
}
__device__ __forceinline__ void prologue(const Frame& F, const Args& a) {
    unsigned char* ws = a.ws;
    LAS float* sv = (LAS float*)F.lds; LAS float* part = (LAS float*)(F.lds + 20480);
    for (int i = F.tid; i < 5 * 1024; i += NTHR) { const int v = i >> 10, k = i & 1023; const float cv = v < 4 ? a.in[1][v * 1024 + k] : a.in[3][k]; sv[i] = cv / (1.0f + expf(-cv)); }
    __syncthreads();
    float* mod = (float*)(ws + WS_MOD);
    for (int item = F.bid; item < DEPTH * 96; item += F.G) {
        const int l = item / 96, n0 = (item % 96) * 64, k0 = F.wave * 128;
        const float* W = a.in[4] + (size_t)l * 1024 * 6144 + (size_t)k0 * 6144 + n0 + F.lane;
        float a0 = 0.f, a1 = 0.f, a2 = 0.f, a3 = 0.f, a4 = 0.f;
#pragma unroll 8
        for (int kk = 0; kk < 128; ++kk) { const float w = W[(size_t)kk * 6144]; const int k = k0 + kk;
            a0 += sv[k] * w; a1 += sv[1024 + k] * w; a2 += sv[2048 + k] * w; a3 += sv[3072 + k] * w; a4 += sv[4096 + k] * w; }
        part[(F.wave * 5 + 0) * 64 + F.lane] = a0; part[(F.wave * 5 + 1) * 64 + F.lane] = a1; part[(F.wave * 5 + 2) * 64 + F.lane] = a2;
        part[(F.wave * 5 + 3) * 64 + F.lane] = a3; part[(F.wave * 5 + 4) * 64 + F.lane] = a4;
        __syncthreads();
        if (F.tid < 320) { const int v = F.tid >> 6, ln = F.tid & 63; float s = a.in[5][l * 6144 + n0 + ln];
#pragma unroll
            for (int w = 0; w < 8; ++w) s += part[(w * 5 + v) * 64 + ln];
            mod[(size_t)(l * 5 + v) * 6144 + n0 + ln] = s; }
        __syncthreads();
    }
    if (F.bid == F.G - 1) { float* rc = (float*)(ws + WS_ROPE); float* rs = rc + 1024;
        for (int i = F.tid; i < 1024; i += NTHR) { const int pos = i >> 4, j = i & 15; const float inv = powf(10000.0f, -(float)j / 16.0f); const float ang = (float)pos * inv; rc[i] = cosf(ang); rs[i] = sinf(ang); } }
    __syncthreads();
    LAS float* scr = (LAS float*)(F.lds + F.wave * 16384);
    const int gw = F.bid * NWAVES + F.wave, NGW = F.G * NWAVES;
    constexpr int I_IN = 16 * 112, I_P = 8 * 32, I_O = 16 * 32, I_G = 16 * 88, I_D = 44 * 32, I_L = I_IN + 2 * I_P + I_O + 2 * I_G + I_D;
    for (int it = gw; it < DEPTH * I_L; it += NGW) {
        const int l = it / I_L; int r = it % I_L; unsigned char* wl = ws + WS_W + (size_t)l * WL_STRIDE;
        if (r < I_IN) { transpose_item(a.in[8] + (size_t)l * 1024 * INC, 1024, INC, (bf16*)(wl + WO_IN), 0, 1, scr, r, F.lane); continue; } r -= I_IN;
        if (r < I_P) { transpose_item(a.in[12] + (size_t)l * 512 * 1024, 512, 1024, (bf16*)(wl + WO_P), 0, 0, scr, r, F.lane); continue; } r -= I_P;
        if (r < I_P) { transpose_item(a.in[13] + (size_t)l * 512 * 1024, 512, 1024, (bf16*)(wl + WO_P), 1024, 0, scr, r, F.lane); continue; } r -= I_P;
        if (r < I_O) { transpose_item(a.in[14] + (size_t)l * 1024 * 1024, 1024, 1024, (bf16*)(wl + WO_O), 0, 0, scr, r, F.lane); continue; } r -= I_O;
        if (r < I_G) { transpose_item(a.in[15] + (size_t)l * 1024 * DFF, 1024, DFF, (bf16*)(wl + WO_GU), 0, 2, scr, r, F.lane); continue; } r -= I_G;
        if (r < I_G) { transpose_item(a.in[16] + (size_t)l * 1024 * DFF, 1024, DFF, (bf16*)(wl + WO_GU), 0, 3, scr, r, F.lane); continue; } r -= I_G;
        transpose_item(a.in[17] + (size_t)l * DFF * 1024, DFF, 1024, (bf16*)(wl + WO_D), 0, 0, scr, r, F.lane);
    }
}
__device__ __forceinline__ void norm_phase(const Frame& F, const float* xl, const float* xc, float* Xcopy, bf16* H, const float* g, const float* modl, int shidx, int M) {
    const int gw = F.bid * NWAVES + F.wave, NGW = F.G * NWAVES;
    f32x4 gv[4];
#pragma unroll
    for (int j = 0; j < 4; ++j) gv[j] = *(const f32x4*)(g + 4 * F.lane + 256 * j);
    for (int row = gw; row < M; row += NGW) {
        const int v = row < MLAT ? row >> 12 : 4;
        const float* xr = row < MLAT ? xl + (size_t)row * DM : xc + (size_t)(row - MLAT) * DM;
        f32x4 x[4]; float ss = 0.f;
#pragma unroll
        for (int j = 0; j < 4; ++j) { x[j] = *(const f32x4*)(xr + 4 * F.lane + 256 * j); ss += (x[j][0] * x[j][0] + x[j][1] * x[j][1]) + (x[j][2] * x[j][2] + x[j][3] * x[j][3]); }
        const float rstd = 1.0f / sqrtf(wave_sum(ss) * (1.0f / DM) + NORM_EPS);
        const float* mv = modl + v * 6144 + shidx * 1024;
#pragma unroll
        for (int j = 0; j < 4; ++j) { const int col = 4 * F.lane + 256 * j; const f32x4 sh = *(const f32x4*)(mv + col), sc = *(const f32x4*)(mv + 1024 + col);
            const f32x4 h = ((x[j] * rstd) * gv[j]) * (sc + 1.0f) + sh;
            v2u w; w.x = pk2(h[0], h[1]); w.y = pk2(h[2], h[3]); *(v2u*)(H + (size_t)row * DM + col) = w;
            if (Xcopy) *(f32x4*)(Xcopy + (size_t)row * DM + col) = x[j]; }
    }
}
__device__ __forceinline__ void final_norm(const Frame& F, const float* X, float* out, const float* g) {
    const int gw = F.bid * NWAVES + F.wave, NGW = F.G * NWAVES;
    f32x4 gv[4];
#pragma unroll
    for (int j = 0; j < 4; ++j) gv[j] = *(const f32x4*)(g + 4 * F.lane + 256 * j);
    for (int row = gw; row < MLAT; row += NGW) {
        const float* xr = X + (size_t)row * DM; f32x4 x[4]; float ss = 0.f;
#pragma unroll
        for (int j = 0; j < 4; ++j) { x[j] = *(const f32x4*)(xr + 4 * F.lane + 256 * j); ss += (x[j][0] * x[j][0] + x[j][1] * x[j][1]) + (x[j][2] * x[j][2] + x[j][3] * x[j][3]); }
        const float rstd = 1.0f / sqrtf(wave_sum(ss) * (1.0f / DM) + NORM_EPS);
#pragma unroll
        for (int j = 0; j < 4; ++j) *(f32x4*)(out + (size_t)row * DM + 4 * F.lane + 256 * j) = (x[j] * rstd) * gv[j];
    }
}
constexpr int AK_PITCH = 144, AV_PITCH = 144, AK_BYTES = 64 * AK_PITCH, AV_BYTES = 64 * AV_PITCH, AV_OFF = 2 * AK_BYTES;
typedef float f32x2_t __attribute__((ext_vector_type(2))); typedef __bf16 bf16x2_t __attribute__((ext_vector_type(2)));
__device__ __forceinline__ unsigned cvtpk(float lo, float hi) { f32x2_t v = {lo, hi}; bf16x2_t b = __builtin_convertvector(v, bf16x2_t); return __builtin_bit_cast(unsigned, b); }
#define MX3(a, b, c) __builtin_fmaxf(__builtin_fmaxf((a), (b)), (c))
constexpr float ATT_THR = 8.0f;
__device__ __forceinline__ void attn_unit(const Frame& F, const bf16* Qb, const bf16* Kb, const bf16* VTb, bf16* Yb, int kvh, int qs, int yrow0, int ta, int tb, bool wmask, bool has_sink, const float* sink) {
    const int tid = F.tid, lane = F.lane, r32 = lane & 31, hi = lane >> 5, wave = F.wave;
    const int head = kvh * 4 + (wave >> 1), qrow = qs + 32 * (wave & 1) + r32;
    const bf16* qp = Qb + ((size_t)head * SALL + qrow) * 64 + hi * 8;
    bf16x8 qr[4];
#pragma unroll
    for (int d0 = 0; d0 < 4; ++d0) qr[d0] = *(const bf16x8*)(qp + 16 * d0);
    const int nl = tb - ta, nt = nl + 4, qt = qs >> 6;
    const int srow = tid >> 3, sch = tid & 7;
    const bf16* kg = Kb + (size_t)srow * 64 + sch * 8;
    const bf16* vg = VTb + (size_t)srow * SALL + sch * 8;
    LAS unsigned char* kw = F.lds + srow * AK_PITCH + sch * 16;
    LAS unsigned char* vw = F.lds + AV_OFF + srow * AV_PITCH + (sch >> 1) * 32 + (sch & 1) * 8;
#define ATT_TILE(i) ((i) < nl ? ta + (i) : 64 + (i) - nl)
    v4u kr[2], vr[2];
    { const int t = ATT_TILE(0), t1 = ATT_TILE(1); kr[0] = *(const v4u*)(kg + (size_t)t * 4096); vr[0] = *(const v4u*)(vg + t * 64); kr[1] = *(const v4u*)(kg + (size_t)t1 * 4096); vr[1] = *(const v4u*)(vg + t1 * 64); }
    *(LAS v4u*)kw = kr[0]; *(LAS v2u*)vw = (v2u){vr[0].x, vr[0].y}; *(LAS v2u*)(vw + 16) = (v2u){vr[0].z, vr[0].w};
    const float sink2 = has_sink ? sink[head] * LOG2E : 0.0f;
    float mref = sink2, lrun = 0.f;
    f32x16 o0, o1, negm;
#pragma unroll
    for (int r = 0; r < 16; ++r) { o0[r] = 0.f; o1[r] = 0.f; negm[r] = -mref; }
    __syncthreads();
    for (int ii = 0; ii < nt; ii += 2) {
#pragma unroll
      for (int h = 0; h < 2; ++h) { const int i = ii + h; if (i < nt) {
        const int cur = i & 1, t = ATT_TILE(i);
        const bool more = i + 1 < nt;
        if (i + 2 < nt) { const int t2 = ATT_TILE(i + 2); kr[h] = *(const v4u*)(kg + (size_t)t2 * 4096); vr[h] = *(const v4u*)(vg + t2 * 64); }
        f32x16 s0 = negm, s1 = negm;
        const LAS unsigned char* kb = F.lds + cur * AK_BYTES + r32 * AK_PITCH + hi * 16;
        const LAS unsigned char* vb = F.lds + AV_OFF + cur * AV_BYTES + r32 * AV_PITCH + hi * 16;
        bf16x8 kf0[4], kf1[4];
#pragma unroll
        for (int d0 = 0; d0 < 4; ++d0) { kf0[d0] = *(const LAS bf16x8*)(kb + d0 * 32); kf1[d0] = *(const LAS bf16x8*)(kb + 32 * AK_PITCH + d0 * 32); }
        __builtin_amdgcn_sched_barrier(0);
#pragma unroll
        for (int d0 = 0; d0 < 4; ++d0) { s0 = __builtin_amdgcn_mfma_f32_32x32x16_bf16(kf0[d0], qr[d0], s0, 0, 0, 0); s1 = __builtin_amdgcn_mfma_f32_32x32x16_bf16(kf1[d0], qr[d0], s1, 0, 0, 0); }
        __builtin_amdgcn_sched_barrier(0);
        bf16x8 vfa[4], vfb[4];
#pragma unroll
        for (int c = 0; c < 4; ++c) { vfa[c] = *(const LAS bf16x8*)(vb + c * 32); vfb[c] = *(const LAS bf16x8*)(vb + 32 * AV_PITCH + c * 32); }
        __builtin_amdgcn_sched_barrier(0);
        if (wmask && t < 64 && (t == qt - 2 || t == qt + 2)) {
            const int kb0 = t * 64 + 4 * hi - qrow;
#pragma unroll
            for (int r = 0; r < 16; ++r) { const int rel = kb0 + (r & 3) + 8 * (r >> 2); if (rel > 128 || rel < -128) s0[r] = -1e30f; if (rel + 32 > 128 || rel + 32 < -128) s1[r] = -1e30f; }
        }
        float ma = MX3(s0[0], s0[1], s1[0]), mb = MX3(s0[2], s0[3], s1[1]); ma = MX3(ma, s1[2], s1[3]);
#pragma unroll
        for (int r = 4; r < 16; r += 4) { ma = MX3(ma, s0[r], s0[r + 1]); mb = MX3(mb, s0[r + 2], s0[r + 3]); ma = MX3(ma, s1[r], s1[r + 1]); mb = MX3(mb, s1[r + 2], s1[r + 3]); }
        float rm = __builtin_fmaxf(ma, mb); rm = __builtin_fmaxf(rm, __shfl_xor(rm, 32));
        const bool first = (i == 0) && !has_sink;
        if (first || __any(rm > ATT_THR)) {
            const float dl = first ? rm : __builtin_fmaxf(rm, 0.f);
            mref += dl;
#pragma unroll
            for (int r = 0; r < 16; ++r) { s0[r] -= dl; s1[r] -= dl; negm[r] = -mref; }
            if (!first) { const float f = __builtin_amdgcn_exp2f(-dl); lrun *= f;
#pragma unroll
                for (int r = 0; r < 16; ++r) { o0[r] *= f; o1[r] *= f; } }
        }
        f32x2_t ls2 = {0.f, 0.f};
#pragma unroll
        for (int r = 0; r < 16; r += 2) { s0[r] = __builtin_amdgcn_exp2f(s0[r]); s0[r + 1] = __builtin_amdgcn_exp2f(s0[r + 1]); s1[r] = __builtin_amdgcn_exp2f(s1[r]); s1[r + 1] = __builtin_amdgcn_exp2f(s1[r + 1]);
            ls2 += (f32x2_t){s0[r], s0[r + 1]}; ls2 += (f32x2_t){s1[r], s1[r + 1]}; }
        lrun += ls2.x + ls2.y;
        bf16x8 pf[4];
#pragma unroll
        for (int c = 0; c < 2; ++c) { v4u w0, w1;
            w0.x = cvtpk(s0[8 * c + 0], s0[8 * c + 1]); w0.y = cvtpk(s0[8 * c + 2], s0[8 * c + 3]); w0.z = cvtpk(s0[8 * c + 4], s0[8 * c + 5]); w0.w = cvtpk(s0[8 * c + 6], s0[8 * c + 7]);
            w1.x = cvtpk(s1[8 * c + 0], s1[8 * c + 1]); w1.y = cvtpk(s1[8 * c + 2], s1[8 * c + 3]); w1.z = cvtpk(s1[8 * c + 4], s1[8 * c + 5]); w1.w = cvtpk(s1[8 * c + 6], s1[8 * c + 7]);
            pf[c] = __builtin_bit_cast(bf16x8, w0); pf[2 + c] = __builtin_bit_cast(bf16x8, w1); }
#pragma unroll
        for (int c = 0; c < 4; ++c) {
            o0 = __builtin_amdgcn_mfma_f32_32x32x16_bf16(vfa[c], pf[c], o0, 0, 0, 0); o1 = __builtin_amdgcn_mfma_f32_32x32x16_bf16(vfb[c], pf[c], o1, 0, 0, 0);
        }
        if (more) { const int nb = cur ^ 1; *(LAS v4u*)(kw + nb * AK_BYTES) = kr[h ^ 1]; *(LAS v2u*)(vw + nb * AV_BYTES) = (v2u){vr[h ^ 1].x, vr[h ^ 1].y}; *(LAS v2u*)(vw + nb * AV_BYTES + 16) = (v2u){vr[h ^ 1].z, vr[h ^ 1].w}; }
        __syncthreads();
      } }
    }
#undef ATT_TILE
    lrun += __shfl_xor(lrun, 32);
    if (has_sink) lrun += __builtin_amdgcn_exp2f(sink2 - mref);
    const float inv = 1.0f / lrun;
    bf16* yp = Yb + (size_t)(yrow0 + 32 * (wave & 1) + r32) * 512 + head * 64 + 4 * hi;
#pragma unroll
    for (int r4 = 0; r4 < 4; ++r4) { v2u w; w.x = cvtpk(o0[4 * r4] * inv, o0[4 * r4 + 1] * inv); w.y = cvtpk(o0[4 * r4 + 2] * inv, o0[4 * r4 + 3] * inv); *(v2u*)(yp + 8 * r4) = w;
        w.x = cvtpk(o1[4 * r4] * inv, o1[4 * r4 + 1] * inv); w.y = cvtpk(o1[4 * r4 + 2] * inv, o1[4 * r4 + 3] * inv); *(v2u*)(yp + 32 + 8 * r4) = w; }
}
__device__ __forceinline__ void attn_phase(const Frame& F, const bf16* Q, const bf16* K, const bf16* VT, bf16* Y, const float* sink, int nunits) {
    for (int U = F.bid; U < nunits; U += F.G) {
        int br, grp, qblk; bool isctx = false;
        if (U < 512) { br = 1; grp = U & 7; qblk = U >> 3; }
        else if (U < 1024) { br = 0; grp = U & 7; qblk = (U - 512) >> 3; }
        else { const int u2 = U - 1024; isctx = true; br = u2 >> 5; grp = (u2 >> 2) & 7; qblk = u2 & 3; }
        const int b = grp >> 1, kvh = grp & 1;
        const bf16* Qb = Q + (size_t)(br * NB + b) * 8 * SALL * 64;
        const bf16* Kb = K + (size_t)((br * NB + b) * 2 + kvh) * SALL * 64;
        const bf16* VTb = VT + (size_t)((br * NB + b) * 2 + kvh) * 64 * SALL;
        bf16* Yb = Y + (size_t)br * MALL * 512;
        int ta = 0, tb = 0; bool wmask = false;
        if (!isctx) { if (br == 1) { ta = 0; tb = 64; } else { ta = qblk - 2 < 0 ? 0 : qblk - 2; tb = qblk + 3 > 64 ? 64 : qblk + 3; wmask = true; } }
        const int qs = isctx ? SEQ + 64 * qblk : 64 * qblk;
        const int yrow0 = isctx ? MLAT + b * CTXL + 64 * qblk : b * SEQ + 64 * qblk;
        attn_unit(F, Qb, Kb, VTb, Yb, kvh, qs, yrow0, ta, tb, wmask, br == 0, sink);
    }
}
typedef GAS unsigned gu32;
typedef GAS unsigned long long gu64;
#define RLX_AGENT __ATOMIC_RELAXED, __HIP_MEMORY_SCOPE_AGENT
#define XB_TMO      128
#define XB_XCNT(j)  (256  + 64 * (j))
#define XB_XSUB(j)  (1280 + 64 * (j))
#define XB_XGEN(j)  (2304 + 64 * (j))
#define XB_TOP      3328
#define XB_TOPGEN   3392
#define XCD_BAR_WORDS 3456
#define XB_SPIN_CAP (1u << 18)

__device__ __forceinline__ unsigned xb_ld(unsigned* p)              { return __hip_atomic_load(p, __ATOMIC_RELAXED, __HIP_MEMORY_SCOPE_AGENT); }
__device__ __forceinline__ unsigned xb_add(unsigned* p, unsigned v) { return __hip_atomic_fetch_add(p, v, __ATOMIC_RELAXED, __HIP_MEMORY_SCOPE_AGENT); }
__device__ __forceinline__ unsigned xb_xcc_id() { return (unsigned)__builtin_amdgcn_s_getreg((3 << 11) | 20) & 0xFu; }
#define XB_SPIN(cond, bar) do { unsigned _sp = 0; while (cond) { __builtin_amdgcn_s_sleep(1); \
    if ((++_sp & 255u) == 0u) { if (xb_ld(&(bar)[XB_TMO])) break; if (_sp > XB_SPIN_CAP) { atomicAdd(&(bar)[XB_TMO], 1u); break; } } } } while (0)

struct XcdBarrier {
    unsigned* bar; unsigned x;
    volatile LAS unsigned* st;
};

__device__ __forceinline__ XcdBarrier xcd_barrier_post(unsigned* bar, volatile LAS unsigned* st) {
    XcdBarrier b; b.bar = bar; b.x = xb_xcc_id(); b.st = st;
    if (threadIdx.x == 0) (void)xb_add(&bar[XB_XCNT(b.x)], 1u);
    return b;
}
__device__ __forceinline__ void xcd_barrier_complete(unsigned* bar, unsigned x, unsigned& nloc, unsigned& nx) {
    const unsigned G = gridDim.x * gridDim.y * gridDim.z;
    unsigned sum, cnt, mine, sp = 0u;
    for (;;) {
        sum = 0u; cnt = 0u; mine = 0u;
#pragma unroll
        for (unsigned j = 0; j < 16; ++j) { const unsigned c = xb_ld(&bar[XB_XCNT(j)]); sum += c; cnt += (c > 0u) ? 1u : 0u; mine = (j == x) ? c : mine; }
        if (sum == G) break;
        __builtin_amdgcn_s_sleep(1);
        if ((++sp & 255u) == 0u) { if (xb_ld(&bar[XB_TMO])) break; if (sp > XB_SPIN_CAP) { atomicAdd(&bar[XB_TMO], 1u); break; } }
    }
    nloc = mine > 0u ? mine : 1u; nx = cnt > 0u ? cnt : 1u;
}

__device__ __forceinline__ void xcd_barrier(const XcdBarrier& b) {
    asm volatile("s_waitcnt vmcnt(0)" ::: "memory");
    __syncthreads();
    if (threadIdx.x == 0) {
        unsigned* bar = b.bar;
        __builtin_amdgcn_s_waitcnt(0);
        unsigned nloc = b.st[0], nx = b.st[1];
        if (nloc == 0u) { xcd_barrier_complete(bar, b.x, nloc, nx); b.st[0] = nloc; b.st[1] = nx; }
        const unsigned old = xb_add(&bar[XB_XSUB(b.x)], 1u);
        const unsigned gen = old / nloc;
        if (old + 1u == (gen + 1u) * nloc) {
            __builtin_amdgcn_fence(__ATOMIC_RELEASE, "agent");
            asm volatile("s_waitcnt vmcnt(0)" ::: "memory");
            const unsigned og = xb_add(&bar[XB_TOP], 1u);
            const unsigned tg = og / nx;
            if (og + 1u == (tg + 1u) * nx) xb_add(&bar[XB_TOPGEN], 1u);
            else XB_SPIN(xb_ld(&bar[XB_TOPGEN]) == tg, bar);
            __builtin_amdgcn_fence(__ATOMIC_ACQUIRE, "agent");
            xb_add(&bar[XB_XGEN(b.x)], 1u);
            asm volatile("s_waitcnt vmcnt(0)" ::: "memory");
        } else {
            XB_SPIN(xb_ld(&bar[XB_XGEN(b.x)]) == gen, bar);
            __builtin_amdgcn_fence(__ATOMIC_ACQUIRE, "agent");
            asm volatile("s_waitcnt vmcnt(0)" ::: "memory");
        }
    }
    __syncthreads();
}

__device__ __forceinline__ void mini_block(const bf16* A, int lda, const bf16* Bt, int ldb, int K, f32x4& c0, f32x4& c1, int lane) {
    const int fr = lane & 15, fq = lane >> 4;
    const bf16* ap = A + (size_t)fr * lda + 8 * fq;
    const bf16* b0p = Bt + (size_t)fr * ldb + 8 * fq; const bf16* b1p = b0p + (size_t)16 * ldb;
    bf16x8 a0[4], p0[4], q0[4], a1[4], p1[4], q1[4];
#define MINI_LD(a, p, q, kk) do { _Pragma("unroll") for (int u = 0; u < 4; ++u) { a[u] = *(const bf16x8*)(ap + (kk) + 32 * u); p[u] = *(const bf16x8*)(b0p + (kk) + 32 * u); q[u] = *(const bf16x8*)(b1p + (kk) + 32 * u); } } while (0)
#define MINI_MM(a, p, q) do { _Pragma("unroll") for (int u = 0; u < 4; ++u) { c0 = __builtin_amdgcn_mfma_f32_16x16x32_bf16(p[u], a[u], c0, 0, 0, 0); c1 = __builtin_amdgcn_mfma_f32_16x16x32_bf16(q[u], a[u], c1, 0, 0, 0); } } while (0)
    MINI_LD(a0, p0, q0, 0);
    for (int k = 0; k < K; k += 256) {
        MINI_LD(a1, p1, q1, k + 128);
        MINI_MM(a0, p0, q0);
        if (k + 256 < K) MINI_LD(a0, p0, q0, k + 256);
        MINI_MM(a1, p1, q1);
    }
#undef MINI_LD
#undef MINI_MM
}
__device__ __forceinline__ unsigned long long pack4u(f32x4 v) { return (unsigned long long)pk2(v[0], v[1]) | ((unsigned long long)pk2(v[2], v[3]) << 32); }
__device__ __forceinline__ f32x4 unpack4u(v2u w) { f32x4 v; v[0] = __uint_as_float(w.x << 16); v[1] = __uint_as_float(w.x & 0xffff0000u); v[2] = __uint_as_float(w.y << 16); v[3] = __uint_as_float(w.y & 0xffff0000u); return v; }
__device__ __forceinline__ void ctx_merge_tiles(const Frame& F, const bf16* Y, const bf16* Wp, const bf16* SG, bf16* Mb) {
    const int fr = F.lane & 15, fq = F.lane >> 4, wi = F.wave >> 1, wj = F.wave & 1;
    for (int t = F.bid; t < 256; t += F.G) {
        const int row0 = MLAT + 64 * (t >> 4) + 16 * wi, col0 = 64 * (t & 15) + 32 * wj;
        f32x4 a0 = {0.f, 0.f, 0.f, 0.f}, a1 = a0, b0 = a0, b1 = a0;
        mini_block(Y + (size_t)row0 * 512, 512, Wp + (size_t)col0 * 512, 512, 512, a0, a1, F.lane);
        mini_block(Y + ((size_t)MALL + row0) * 512, 512, Wp + (size_t)(1024 + col0) * 512, 512, 512, b0, b1, F.lane);
        const size_t off = (size_t)(row0 + fr) * 1024 + col0 + 4 * fq;
        const f32x4 sa0 = unpack4u(*(const v2u*)(SG + off)), sa1 = unpack4u(*(const v2u*)(SG + off + 16));
        const f32x4 sb0 = unpack4u(*(const v2u*)(SG + (size_t)MALL * 1024 + off)), sb1 = unpack4u(*(const v2u*)(SG + (size_t)MALL * 1024 + off + 16));
        *(unsigned long long*)(Mb + off) = pack4u(sa0 * a0 + sb0 * b0); *(unsigned long long*)(Mb + off + 16) = pack4u(sa1 * a1 + sb1 * b1);
    }
}
__device__ __forceinline__ void ctx_resid_tiles(const Frame& F, const bf16* A, int K, const bf16* Bt, const float* gate_ctx, float* X) {
    const int fr = F.lane & 15, fq = F.lane >> 4, wi = F.wave >> 1, wj = F.wave & 1;
    for (int t = F.bid; t < 256; t += F.G) {
        const int row0 = MLAT + 64 * (t >> 4) + 16 * wi, col0 = 64 * (t & 15) + 32 * wj;
        f32x4 c0 = {0.f, 0.f, 0.f, 0.f}, c1 = c0;
        float* xp = X + (size_t)(row0 + fr) * 1024 + col0 + 4 * fq;
        const f32x4 x0 = *(const f32x4*)xp, x1 = *(const f32x4*)(xp + 16);
        const f32x4 g0 = *(const f32x4*)(gate_ctx + col0 + 4 * fq), g1 = *(const f32x4*)(gate_ctx + col0 + 4 * fq + 16);
        mini_block(A + (size_t)row0 * K, K, Bt + (size_t)col0 * K, K, K, c0, c1, F.lane);
        *(f32x4*)xp = x0 + g0 * c0; *(f32x4*)(xp + 16) = x1 + g1 * c1;
    }
}
__global__ void __launch_bounds__(NTHR, 2) fwd_megakernel(Args args) {
    extern __shared__ __attribute__((aligned(16))) unsigned char lds_raw[];
    cg::grid_group grid = cg::this_grid();
    Frame F;
#define MKFRAME() do { int t_ = threadIdx.x; asm volatile("" : "+v"(t_)); F.lds = (LAS unsigned char*)lds_raw; F.tid = t_; F.lane = t_ & 63; F.wave = __builtin_amdgcn_readfirstlane(t_ >> 6); F.G = gridDim.x; F.bid = blockIdx.x; } while (0)
    MKFRAME();
    unsigned char* ws = args.ws;
    float* X = (float*)(ws + WS_X); bf16* H = (bf16*)(ws + WS_H); bf16* Qb = (bf16*)(ws + WS_Q); bf16* Kb = (bf16*)(ws + WS_K); bf16* VTb = (bf16*)(ws + WS_VT);
    bf16* SG = (bf16*)(ws + WS_SG); bf16* Y = (bf16*)(ws + WS_Y); bf16* HF = (bf16*)(ws + WS_HF);
    const float* mod = (const float*)(ws + WS_MOD); const float* rc = (const float*)(ws + WS_ROPE); const float* rs = rc + 1024;
    volatile LAS unsigned* MISC = (volatile LAS unsigned*)((LAS unsigned char*)lds_raw + RING_BYTES + 320);
    if (threadIdx.x < 32) MISC[threadIdx.x] = 0u;
    __syncthreads();
    XcdBarrier bar = xcd_barrier_post((unsigned*)(ws + 4096 * 4), MISC + 8);
    prologue(F, args);
    grid.sync();
    LAS float* ropel = (LAS float*)((LAS unsigned char*)lds_raw + RING_BYTES + 1024);
    for (int i = threadIdx.x; i < 2048; i += NTHR) ropel[i] = rc[i];
    __syncthreads();
    for (int l = 0; l < DEPTH; ++l) {
        const bool last = l == DEPTH - 1;
        const int Mpost = last ? MLAT : MALL;
        const float* modl = mod + (size_t)l * 5 * 6144;
        const unsigned char* wl = ws + WS_W + (size_t)l * WL_STRIDE;
        MKFRAME();
        if (l == 0) norm_phase(F, args.in[0], args.in[2], X, H, args.in[6], modl, 0, MALL);
        else norm_phase(F, X, X + (size_t)MLAT * DM, nullptr, H, args.in[6] + l * DM, modl, 0, MALL);
        xcd_barrier(bar);
        { pg8::Gemm g{H, (const bf16*)(wl + WO_IN), MALL, INC, DM}; pg8::StaticOrder S; S.init(MALL, INC, F.G, F.bid);
          pg8::EpiInProj E{Qb, Kb, VTb, SG, args.in[9] + l * 64, args.in[10] + l * 64, ropel, nullptr, nullptr};
          pg8::gemm_phase<pg8::EpiInProj, pg8::StaticOrder, true, true>(F.lds, g, S, E); }
        xcd_barrier(bar);
        MKFRAME();
        attn_phase(F, Qb, Kb, VTb, Y, args.in[11] + l * 8, last ? 1024 : 1088);
        xcd_barrier(bar);
        { pg8::Gemm g{Y, (const bf16*)(wl + WO_P), MLAT, DM, 512}; pg8::PairedOrder S; S.base.init(MLAT, DM, F.G, F.bid); S.dM = NPAN_ALL; S.dN = 4;
          pg8::EpiMerge E{SG, H};
          pg8::gemm_phase<pg8::EpiMerge, pg8::PairedOrder, true, true>(F.lds, g, S, E); }
        if (!last) { MKFRAME(); ctx_merge_tiles(F, Y, (const bf16*)(wl + WO_P), SG, H); }
        xcd_barrier(bar);
        { pg8::Gemm g{H, (const bf16*)(wl + WO_O), MLAT, DM, DM}; pg8::StaticOrder S; S.init(MLAT, DM, F.G, F.bid);
          pg8::EpiResid E{modl + 2 * 1024, X, nullptr, nullptr, nullptr, nullptr};
          pg8::gemm_phase<pg8::EpiResid, pg8::StaticOrder, true, true>(F.lds, g, S, E); }
        if (!last) { MKFRAME(); ctx_resid_tiles(F, H, DM, (const bf16*)(wl + WO_O), modl + 4 * 6144 + 2 * 1024, X); }
        xcd_barrier(bar);
        MKFRAME();
        norm_phase(F, X, X + (size_t)MLAT * DM, nullptr, H, args.in[7] + l * DM, modl, 3, Mpost);
        xcd_barrier(bar);
        { pg8::Gemm g{H, (const bf16*)(wl + WO_GU), Mpost, NGU, DM}; pg8::StaticOrder S; S.init(Mpost, NGU, F.G, F.bid);
          pg8::EpiSwiGLU E{HF};
          pg8::gemm_phase<pg8::EpiSwiGLU, pg8::StaticOrder, true, true>(F.lds, g, S, E); }
        xcd_barrier(bar);
        { pg8::Gemm g{HF, (const bf16*)(wl + WO_D), MLAT, DM, DFF}; pg8::StaticOrder S; S.init(MLAT, DM, F.G, F.bid);
          pg8::EpiResid E{modl + 5 * 1024, X, nullptr, nullptr, nullptr, nullptr};
          pg8::gemm_phase<pg8::EpiResid, pg8::StaticOrder, true, true>(F.lds, g, S, E); }
        if (!last) { MKFRAME(); ctx_resid_tiles(F, HF, DFF, (const bf16*)(wl + WO_D), modl + 4 * 6144 + 5 * 1024, X); }
        xcd_barrier(bar);
    }
    MKFRAME();
    final_norm(F, X, args.out, args.in[18]);
}

extern "C" void kernel_launch(void* const* d_in, const int* in_sizes, int n_in, void* d_out, int out_size, void* d_ws, size_t ws_size, hipStream_t stream) {
    static int grid = 0;
    if (grid == 0) {
        if (n_in != 19 || ws_size < WS_END) { fprintf(stderr, "kernel_launch: need 19 inputs and >= %zu bytes of workspace (got %d, %zu)\n", (size_t)WS_END, n_in, ws_size); grid = -1; return; }
        int dev = 0, cus = 0, per_cu = 0;
        hipGetDevice(&dev); hipDeviceGetAttribute(&cus, hipDeviceAttributeMultiprocessorCount, dev);
        hipFuncSetAttribute((const void*)fwd_megakernel, hipFuncAttributeMaxDynamicSharedMemorySize, LDS_BYTES);
        if (hipOccupancyMaxActiveBlocksPerMultiprocessor(&per_cu, (const void*)fwd_megakernel, NTHR, LDS_BYTES) != hipSuccess || per_cu < 1) { fprintf(stderr, "kernel_launch: occupancy query says %d\n", per_cu); per_cu = 1; }
        (void)hipGetLastError();
        grid = cus * per_cu;
    }
    if (grid < 0) return;
    if (hipMemsetAsync(d_ws, 0, 65536, stream) != hipSuccess) { fprintf(stderr, "kernel_launch: memset of the barrier words failed\n"); return; }
    Args a{};
    for (int i = 0; i < 19; ++i) a.in[i] = (const float*)d_in[i];
    a.out = (float*)d_out; a.ws = (unsigned char*)d_ws;
    void* kargs[] = {&a};
    hipError_t e = hipLaunchCooperativeKernel((const void*)fwd_megakernel, dim3(grid), dim3(NTHR), kargs, LDS_BYTES, stream);
    if (e != hipSuccess) fprintf(stderr, "cooperative launch failed: %s (grid %d)\n", hipGetErrorString(e), grid);
}
```

```cpp
#include <hip/hip_runtime.h>
#include <hip/hip_cooperative_groups.h>
#include <cstdio>
#include <cstdint>
namespace cg = cooperative_groups;

constexpr int DM = 1024, NB = 4, SEQ = 4096, DEPTH = 4, CTXL = 256, SALL = SEQ + CTXL, MLAT = NB * SEQ, MCTX = NB * CTXL, MALL = MLAT + MCTX;
constexpr int INC = 3584, DFF = 2816, NGU = 2 * DFF, NPAN_ALL = MALL / 256;
constexpr float NORM_EPS = 1e-6f;
constexpr float QSCALE = 0.125f * 1.4426950408889634f;
constexpr float LOG2E = 1.4426950408889634f;
namespace pg8 {
#define PG8_LAS __attribute__((address_space(3)))
typedef unsigned short bf16_t;
typedef short bf16x8 __attribute__((ext_vector_type(8)));
typedef float f32x4 __attribute__((ext_vector_type(4)));
typedef unsigned u32x4 __attribute__((ext_vector_type(4)));
constexpr int BM = 256, BK = 64, HALF = 128, HTB = HALF * BK * 2  , STAGE_BYTES = 8 * HTB, NXCD = 8, WGM = 8;

__host__ __device__ __forceinline__ int lds_byte(int r, int c) { const int st = (r >> 4) * 2 + (c >> 5), rr = r & 15, cc = c & 31, ob = rr * 64 + cc * 2; return st * 1024 + (ob ^ (((ob >> 9) & 1) << 5)); }
__host__ __device__ __forceinline__ void stage_rc(int b, int& R, int& C) { const int st = b / 1024, sb = b % 1024, swz = sb ^ (((sb >> 9) & 1) << 5); R = (st >> 1) * 16 + swz / 64; C = (st & 1) * 32 + (swz % 64) / 2; }
__host__ __device__ __forceinline__ int perm32(int rho) { const int n = rho >> 4, i = rho & 15; return 8 * (i >> 2) + 4 * n + (i & 3); }

struct Unit { int pm, pn; };
struct Gemm { const bf16_t* A; const bf16_t* Bt; int M, N, K; };

struct StaticOrder {
    int nM, nN, nwg, G, c;
    __host__ __device__ void init(int M, int N, int G_, int c_) { nM = M / BM; nN = N / BM; nwg = nM * nN; G = G_; c = c_; }
    __host__ __device__ bool next(int i, Unit& u) const {
        const long L = (long)i * G + c; if (L >= nwg) return false;
        int wgid = (int)L; { const int q = nwg / NXCD, r = nwg % NXCD, xcd = wgid % NXCD, off = wgid / NXCD; wgid = (xcd < r ? xcd * (q + 1) : r * (q + 1) + (xcd - r) * q) + off; }
        const int nig = WGM * nN, gid = wgid / nig, fm = gid * WGM, gsz = (nM - fm) < WGM ? (nM - fm) : WGM;
        u.pm = fm + ((wgid % nig) % gsz); u.pn = (wgid % nig) / gsz; return true;
    }
    __device__ __forceinline__ void a_ready(const Unit&) const {}
    __device__ __forceinline__ void done(const Unit&) const {}
};

__device__ __forceinline__ unsigned cvt_pk_bf16(float lo, float hi) { unsigned r; asm volatile("v_cvt_pk_bf16_f32 %0, %1, %2" : "=v"(r) : "v"(lo), "v"(hi)); return r; }
typedef float f32x2 __attribute__((ext_vector_type(2)));
typedef unsigned u32x2 __attribute__((ext_vector_type(2)));
typedef float f32x2c __attribute__((ext_vector_type(2))); typedef __bf16 bf16x2c __attribute__((ext_vector_type(2)));
__device__ __forceinline__ unsigned cvt2(float lo, float hi) { f32x2c v = {lo, hi}; bf16x2c b = __builtin_convertvector(v, bf16x2c); return __builtin_bit_cast(unsigned, b); }
__device__ __forceinline__ u32x2 pack4(f32x4 v) { u32x2 w; w.x = cvt2(v[0], v[1]); w.y = cvt2(v[2], v[3]); return w; }
__device__ __forceinline__ f32x4 unpack4(u32x2 w) { f32x4 v; v[0] = __uint_as_float(w.x << 16); v[1] = __uint_as_float(w.x & 0xffff0000u); v[2] = __uint_as_float(w.y << 16); v[3] = __uint_as_float(w.y & 0xffff0000u); return v; }
__device__ __forceinline__ float sigmoidf_(float v) { return __builtin_amdgcn_rcpf(1.0f + __builtin_amdgcn_exp2f(v * -1.4426950408889634f)); }

struct EpiInProj {
    static constexpr bool PERM = false, AFTER_DRAIN = false;
    static __device__ __forceinline__ bool keep(const Unit&) { return false; }
    bf16_t *Q, *K, *VT, *SG; const float *qg, *kg; const PG8_LAS float* ropel; const float* rowss; const float* bias;
    __device__ __forceinline__ void operator()(f32x4 (&acc)[2][2][4][2], const Unit& u, int wr, int wc, int fr, int fq) const {
        const int pn = u.pn; const int vb = u.pm < (MLAT / 256) ? (u.pm >> 4) : 4;
        const int row0 = u.pm * 256 + wr * 64 + fr;
        float rstd[2][4]; f32x4 bv[2][2];
#pragma unroll
        for (int ai = 0; ai < 2; ++ai)
#pragma unroll
            for (int m = 0; m < 4; ++m) rstd[ai][m] = rowss ? rowss[row0 + ai * 128 + m * 16] : 0.f;
#pragma unroll
        for (int bj = 0; bj < 2; ++bj)
#pragma unroll
            for (int n = 0; n < 2; ++n) bv[bj][n] = rowss ? *(const f32x4*)(bias + vb * INC + pn * 256 + 128 * bj + 32 * wc + 16 * n + 4 * fq) : (f32x4){0.f, 0.f, 0.f, 0.f};
        const int br = (pn >= 6) ? ((pn - 6) >> 2) : (pn >= 3 ? 1 : 0), pl = pn - 3 * br;
        const bool isQ = pl < 2, isV = (!isQ) && wc >= 2, donorm = (pn < 6) && (br == 1) && !isV;
        const float* gvec = isQ ? qg : kg;
        f32x4 gl[2][2];
#pragma unroll
        for (int bj = 0; bj < 2; ++bj)
#pragma unroll
            for (int n = 0; n < 2; ++n) gl[bj][n] = donorm ? *(const f32x4*)(gvec + 32 * bj + 16 * n + 4 * fq) : (f32x4){1.f, 1.f, 1.f, 1.f};
#pragma unroll
        for (int ai = 0; ai < 2; ++ai)
#pragma unroll
            for (int m = 0; m < 4; ++m) rstd[ai][m] = rowss ? 1.0f / sqrtf(rstd[ai][m] * (1.0f / 1024.0f) + NORM_EPS) : 1.0f;
        if (pn >= 6) {
            const int cbase = ((pn - 6) & 3) * 256 + wc * 64 + 4 * fq;
#pragma unroll
            for (int ai = 0; ai < 2; ++ai)
#pragma unroll
                for (int m = 0; m < 4; ++m) { const int row = row0 + ai * 128 + m * 16; bf16_t* dst = SG + ((size_t)br * MALL + row) * 1024 + cbase;
#pragma unroll
                    for (int bj = 0; bj < 2; ++bj)
#pragma unroll
                        for (int n = 0; n < 2; ++n) { f32x4 v = acc[ai][bj][m][n] * rstd[ai][m] + bv[bj][n];
                            v[0] = sigmoidf_(v[0]); v[1] = sigmoidf_(v[1]); v[2] = sigmoidf_(v[2]); v[3] = sigmoidf_(v[3]);
                            *(u32x2*)(dst + 32 * bj + 16 * n) = pack4(v); } }
            return;
        }
        const int head = isQ ? pl * 4 + wc : (wc & 1);
#pragma unroll
        for (int ai = 0; ai < 2; ++ai)
#pragma unroll
            for (int m = 0; m < 4; ++m) {
                const int row = row0 + ai * 128 + m * 16;
                const bool isctx = row >= MLAT;
                const int b = isctx ? (row - MLAT) >> 8 : row >> 12;
                const int sall = isctx ? SEQ + ((row - MLAT) & 255) : row & (SEQ - 1);
                f32x4 v[2][2];
#pragma unroll
                for (int bj = 0; bj < 2; ++bj)
#pragma unroll
                    for (int n = 0; n < 2; ++n) v[bj][n] = acc[ai][bj][m][n] * rstd[ai][m] + bv[bj][n];
                if (donorm) {
                    float ss = 0.f;
#pragma unroll
                    for (int bj = 0; bj < 2; ++bj)
#pragma unroll
                        for (int n = 0; n < 2; ++n) ss += (v[bj][n][0] * v[bj][n][0] + v[bj][n][1] * v[bj][n][1]) + (v[bj][n][2] * v[bj][n][2] + v[bj][n][3] * v[bj][n][3]);
                    ss += __shfl_xor(ss, 16); ss += __shfl_xor(ss, 32);
                    const float rs_ = 1.0f / sqrtf(ss * (1.0f / 64.0f) + NORM_EPS);
#pragma unroll
                    for (int bj = 0; bj < 2; ++bj)
#pragma unroll
                        for (int n = 0; n < 2; ++n) v[bj][n] = (v[bj][n] * rs_) * gl[bj][n];
                }
                if (!isV && !isctx) {
#pragma unroll
                    for (int bj = 0; bj < 2; ++bj) { const int pos = bj ? (sall & 63) : (sall >> 6);
                        const f32x4 c = *(const PG8_LAS f32x4*)(ropel + pos * 16 + 4 * fq), s = *(const PG8_LAS f32x4*)(ropel + 1024 + pos * 16 + 4 * fq);
                        const f32x4 x1 = v[bj][0], x2 = v[bj][1]; v[bj][0] = x1 * c - x2 * s; v[bj][1] = x2 * c + x1 * s; }
                }
                if (isQ) { bf16_t* dst = Q + ((size_t)((br * NB + b) * 8 + head) * SALL + sall) * 64 + 4 * fq;
#pragma unroll
                    for (int bj = 0; bj < 2; ++bj)
#pragma unroll
                        for (int n = 0; n < 2; ++n) *(u32x2*)(dst + 32 * bj + 16 * n) = pack4(v[bj][n] * QSCALE);
                } else if (!isV) { bf16_t* dst = K + ((size_t)((br * NB + b) * 2 + head) * SALL + sall) * 64 + 4 * fq;
#pragma unroll
                    for (int bj = 0; bj < 2; ++bj)
#pragma unroll
                        for (int n = 0; n < 2; ++n) *(u32x2*)(dst + 32 * bj + 16 * n) = pack4(v[bj][n]);
                } else { bf16_t* dst = VT + ((size_t)((br * NB + b) * 2 + head) * 64 + 4 * fq) * SALL + sall;
#pragma unroll
                    for (int bj = 0; bj < 2; ++bj)
#pragma unroll
                        for (int n = 0; n < 2; ++n) { const u32x2 w = pack4(v[bj][n]); bf16_t* d2 = dst + (size_t)(32 * bj + 16 * n) * SALL;
                            d2[0] = (bf16_t)(w.x & 0xffffu); d2[SALL] = (bf16_t)(w.x >> 16); d2[2 * SALL] = (bf16_t)(w.y & 0xffffu); d2[3 * SALL] = (bf16_t)(w.y >> 16); }
                }
            }
    }
};
struct EpiMerge {
    static constexpr bool PERM = false, AFTER_DRAIN = false;
    static __device__ __forceinline__ bool keep(const Unit& u) { return u.pn < 4; }
    const bf16_t* SG; bf16_t* Mb;
    __device__ __forceinline__ void operator()(f32x4 (&acc)[2][2][4][2], const Unit& u, int wr, int wc, int fr, int fq) const {
        const bool second = u.pn >= 4; const int pn = u.pn & 3, pm = second ? u.pm - NPAN_ALL : u.pm;
        const size_t row0 = (size_t)(pm * 256 + wr * 64 + fr);
#pragma unroll
        for (int bj = 0; bj < 2; ++bj)
#pragma unroll
          for (int n = 0; n < 2; ++n) {
            const int col = pn * 256 + 128 * bj + 32 * wc + 16 * n + 4 * fq;
            u32x2 sbw[2][4], saw[2][4];
#pragma unroll
            for (int ai = 0; ai < 2; ++ai)
#pragma unroll
                for (int m = 0; m < 4; ++m) { const size_t off = (row0 + ai * 128 + m * 16) * 1024 + col;
                    sbw[ai][m] = *(const u32x2*)(SG + (size_t)MALL * 1024 + off); saw[ai][m] = second ? sbw[ai][m] : *(const u32x2*)(SG + off); }
#pragma unroll
            for (int ai = 0; ai < 2; ++ai)
#pragma unroll
                for (int m = 0; m < 4; ++m) { const size_t off = (row0 + ai * 128 + m * 16) * 1024 + col;
                    const f32x4 sb = unpack4(sbw[ai][m]);
                    if (!second) { const f32x4 sa = unpack4(saw[ai][m]); f32x4 rb; rb[0] = __builtin_amdgcn_rcpf(sb[0]); rb[1] = __builtin_amdgcn_rcpf(sb[1]); rb[2] = __builtin_amdgcn_rcpf(sb[2]); rb[3] = __builtin_amdgcn_rcpf(sb[3]); acc[ai][bj][m][n] = acc[ai][bj][m][n] * (sa * rb); }
                    else *(u32x2*)(Mb + off) = pack4(acc[ai][bj][m][n] * sb); }
          }
    }
};
struct EpiResid {
    static constexpr bool PERM = false, AFTER_DRAIN = false;
    static __device__ __forceinline__ bool keep(const Unit&) { return false; }
    const float* gate; float* X;
    bf16_t* XG; float* rowss; const float* ng; const float* nsc;
    __device__ __forceinline__ void operator()(f32x4 (&acc)[2][2][4][2], const Unit& u, int wr, int wc, int fr, int fq) const {
        const int v = u.pm < (MLAT / 256) ? (u.pm >> 4) : 4;
        const size_t row0 = (size_t)(u.pm * 256 + wr * 64 + fr);
        float ssq[2][4];
#pragma unroll
        for (int ai = 0; ai < 2; ++ai)
#pragma unroll
            for (int m = 0; m < 4; ++m) ssq[ai][m] = 0.f;
#pragma unroll
        for (int bj = 0; bj < 2; ++bj)
#pragma unroll
          for (int n = 0; n < 2; ++n) {
            const int col = u.pn * 256 + 128 * bj + 32 * wc + 16 * n + 4 * fq;
            const f32x4 g = *(const f32x4*)(gate + v * 6144 + col);
            f32x4 G = {0.f, 0.f, 0.f, 0.f};
            if (XG) G = *(const f32x4*)(ng + col) * (*(const f32x4*)(nsc + v * 6144 + col) + 1.0f);
            f32x4 xv[2][4];
#pragma unroll
            for (int ai = 0; ai < 2; ++ai)
#pragma unroll
                for (int m = 0; m < 4; ++m) xv[ai][m] = *(const f32x4*)(X + (row0 + ai * 128 + m * 16) * 1024 + col);
#pragma unroll
            for (int ai = 0; ai < 2; ++ai)
#pragma unroll
                for (int m = 0; m < 4; ++m) { const size_t off = (row0 + ai * 128 + m * 16) * 1024 + col;
                    const f32x4 xn = xv[ai][m] + g * acc[ai][bj][m][n]; *(f32x4*)(X + off) = xn;
                    if (XG) { ssq[ai][m] += (xn[0] * xn[0] + xn[1] * xn[1]) + (xn[2] * xn[2] + xn[3] * xn[3]); *(u32x2*)(XG + off) = pack4(xn * G); } }
          }
        if (XG) {
#pragma unroll
            for (int ai = 0; ai < 2; ++ai)
#pragma unroll
                for (int m = 0; m < 4; ++m) { float q = ssq[ai][m]; q += __shfl_xor(q, 16); q += __shfl_xor(q, 32);
                    if (fq == 0) atomicAdd(rowss + row0 + ai * 128 + m * 16, q); }
        }
    }
};
struct EpiSwiGLU {
    static constexpr bool PERM = false, AFTER_DRAIN = false;
    static __device__ __forceinline__ bool keep(const Unit&) { return false; }
    bf16_t* Hf;
    __device__ __forceinline__ void operator()(f32x4 (&acc)[2][2][4][2], const Unit& u, int wr, int wc, int fr, int fq) const {
#pragma unroll
        for (int ai = 0; ai < 2; ++ai)
#pragma unroll
            for (int m = 0; m < 4; ++m) { bf16_t* dst = Hf + (size_t)(u.pm * 256 + ai * 128 + wr * 64 + m * 16 + fr) * DFF + 128 * u.pn + 16 * wc + 4 * fq;
#pragma unroll
                for (int bj = 0; bj < 2; ++bj) { const f32x4 g = acc[ai][bj][m][0], up = acc[ai][bj][m][1]; f32x4 h;
#pragma unroll
                    for (int j = 0; j < 4; ++j) h[j] = g[j] * sigmoidf_(g[j]) * up[j];
                    *(u32x2*)(dst + 64 * bj) = pack4(h); } }
    }
};
struct PairedOrder {
    StaticOrder base; int dM, dN;
    __device__ bool next(int i, Unit& u) const { if (!base.next(i >> 1, u)) return false; if (i & 1) { u.pm += dM; u.pn += dN; } return true; }
    __device__ __forceinline__ void a_ready(const Unit&) const {}
    __device__ __forceinline__ void done(const Unit&) const {}
};
template <class Epi, class Sched, bool ALIGN_EPI = false, bool SP2 = false>
__device__ __forceinline__ void gemm_phase(PG8_LAS unsigned char* lds, const Gemm g, const Sched& S, const Epi& E) {
    int tid_ = threadIdx.x; asm volatile("" : "+v"(tid_));
    const int tid = tid_, wid = __builtin_amdgcn_readfirstlane(tid >> 6), lane = tid & 63, wr = wid >> 2, wc = wid & 3, fr = lane & 15, fq = lane >> 4;
    const int K = g.K, nt = K / BK;
    unsigned voffA[2], voffB[2];
#pragma unroll
    for (int i = 0; i < 2; ++i) { int R, C; stage_rc(tid * 16 + i * 8192, R, C); const int Rb = Epi::PERM ? ((R & ~31) + perm32(R & 31)) : R;
        voffA[i] = (unsigned)(R * K + C) * 2u; voffB[i] = (unsigned)(Rb * K + C) * 2u; }
    const size_t kstep = (size_t)(BK * 2);
    const size_t hstep = (size_t)HALF * K * 2;
    const size_t tstep = 2 * hstep;
    const unsigned ldsw = (unsigned)wid * 1024u;
    const int aoff = lds_byte(wr * 64 + fr, fq * 8), boff = lds_byte(wc * 32 + fr, fq * 8);
#define PG8_SA(b, h) (((b) * 2 + (h)) * HTB)
#define PG8_SB(b, h) ((4 + (b) * 2 + (h)) * HTB)
#define PG8_STAGE(bufoff, gbase, voff) do { _Pragma("unroll") for (int _i = 0; _i < 2; ++_i) \
        __builtin_amdgcn_global_load_lds((const unsigned*)((const char*)(gbase) + (voff)[_i]), (PG8_LAS unsigned*)(lds + (bufoff) + ldsw + _i * 8192), 16, 0, 0); } while (0)
#define PG8_LDA(dst, b, h) do { _Pragma("unroll") for (int m = 0; m < 4; ++m) _Pragma("unroll") for (int k = 0; k < 2; ++k) dst[m][k] = *(const PG8_LAS bf16x8*)(lds + PG8_SA(b, h) + aoff + m * 2048 + k * 1024); } while (0)
#define PG8_LDB(dst, b, h) do { _Pragma("unroll") for (int n = 0; n < 2; ++n) _Pragma("unroll") for (int k = 0; k < 2; ++k) dst[n][k] = *(const PG8_LAS bf16x8*)(lds + PG8_SB(b, h) + boff + n * 2048 + k * 1024); } while (0)
#define PG8_MMA(ai, bj, At, Bt) do { __builtin_amdgcn_s_setprio(1); _Pragma("unroll") for (int m = 0; m < 4; ++m) _Pragma("unroll") for (int n = 0; n < 2; ++n) _Pragma("unroll") for (int k = 0; k < 2; ++k) \
        acc[ai][bj][m][n] = __builtin_amdgcn_mfma_f32_16x16x32_bf16(Bt[n][k], At[m][k], acc[ai][bj][m][n], 0, 0, 0); __builtin_amdgcn_s_setprio(0); } while (0)
#define PG8_WAIT_V(n) asm volatile("s_waitcnt vmcnt(" #n ")" ::: "memory")
#define PG8_WAIT_L(n) asm volatile("s_waitcnt lgkmcnt(" #n ")" ::: "memory")
#define PG8_BAR __builtin_amdgcn_s_barrier()
#define PG8_SCHED __builtin_amdgcn_sched_barrier(0)
    Unit cur, nxt; int ui = 0;
    if (!S.next(0, cur)) return;
    f32x4 acc[2][2][4][2];
#pragma unroll
    for (int a = 0; a < 2; ++a)
#pragma unroll
        for (int b = 0; b < 2; ++b)
#pragma unroll
            for (int m = 0; m < 4; ++m)
#pragma unroll
                for (int n = 0; n < 2; ++n) acc[a][b][m][n] = (f32x4){0.f, 0.f, 0.f, 0.f};
    bf16x8 At[4][2], B0[2][2], B1[2][2];
    const char* cA = (const char*)g.A + (size_t)cur.pm * tstep; const char* cB = (const char*)g.Bt + (size_t)cur.pn * tstep;
    S.a_ready(cur);
    if constexpr (SP2) {
        PG8_STAGE(PG8_SB(0, 0), cB, voffB); PG8_STAGE(PG8_SB(0, 1), cB + hstep, voffB); PG8_STAGE(PG8_SA(0, 0), cA, voffA); PG8_STAGE(PG8_SA(0, 1), cA + hstep, voffA);
        if (wr == 1) PG8_BAR;
        PG8_WAIT_V(2); PG8_BAR;
        PG8_STAGE(PG8_SB(1, 0), cB + kstep, voffB); PG8_STAGE(PG8_SA(1, 0), cA + kstep, voffA); PG8_STAGE(PG8_SB(1, 1), cB + hstep + kstep, voffB);
        PG8_WAIT_V(6); PG8_BAR;
    } else {
        PG8_STAGE(PG8_SB(0, 0), cB, voffB); PG8_STAGE(PG8_SA(0, 0), cA, voffA); PG8_STAGE(PG8_SB(0, 1), cB + hstep, voffB); PG8_STAGE(PG8_SA(0, 1), cA + hstep, voffA);
        if (wr == 1) PG8_BAR;
        PG8_WAIT_V(4); PG8_BAR;
        PG8_STAGE(PG8_SB(1, 0), cB + kstep, voffB); PG8_STAGE(PG8_SA(1, 0), cA + kstep, voffA); PG8_STAGE(PG8_SB(1, 1), cB + hstep + kstep, voffB);
        PG8_WAIT_V(6); PG8_BAR;
    }
    for (;;) {
        const bool has_next = S.next(ui + 1, nxt);
        const char* nA = has_next ? (const char*)g.A + (size_t)nxt.pm * tstep : cA; const char* nB = has_next ? (const char*)g.Bt + (size_t)nxt.pn * tstep : cB;
        for (int t = 0; t < nt; t += 2) {
            const bool last = (t == nt - 2);
            const char* a1 = cA + (size_t)(t + 1) * kstep;
            const char* a2 = last ? nA : cA + (size_t)(t + 2) * kstep; const char* b2 = last ? nB : cB + (size_t)(t + 2) * kstep;
            const char* a3 = a2 + kstep; const char* b3 = b2 + kstep;
            if (last && has_next) S.a_ready(nxt);
            if constexpr (SP2) {
            PG8_LDB(B0, 0, 0); PG8_LDB(B1, 0, 1); PG8_SCHED; PG8_LDA(At, 0, 0); PG8_STAGE(PG8_SA(1, 1), a1 + hstep, voffA);
            PG8_WAIT_V(8); PG8_WAIT_L(0); PG8_BAR; PG8_MMA(0, 0, At, B0); PG8_MMA(0, 1, At, B1); PG8_BAR; PG8_SCHED;
            PG8_LDA(At, 0, 1); PG8_STAGE(PG8_SB(0, 0), b2, voffB); PG8_STAGE(PG8_SB(0, 1), b2 + hstep, voffB); PG8_STAGE(PG8_SA(0, 0), a2, voffA);
            PG8_WAIT_V(8); PG8_WAIT_L(0); PG8_BAR; PG8_MMA(1, 0, At, B0); PG8_MMA(1, 1, At, B1); PG8_BAR; PG8_SCHED;
            PG8_LDB(B0, 1, 0); PG8_LDB(B1, 1, 1); PG8_SCHED; PG8_LDA(At, 1, 0); PG8_STAGE(PG8_SA(0, 1), a2 + hstep, voffA);
            PG8_WAIT_V(8); PG8_WAIT_L(0); PG8_BAR; PG8_MMA(0, 0, At, B0); PG8_MMA(0, 1, At, B1); PG8_BAR; PG8_SCHED;
            PG8_LDA(At, 1, 1); PG8_STAGE(PG8_SB(1, 0), b3, voffB); PG8_STAGE(PG8_SB(1, 1), b3 + hstep, voffB); PG8_STAGE(PG8_SA(1, 0), a3, voffA);
            PG8_WAIT_V(8); PG8_WAIT_L(0); PG8_BAR; PG8_MMA(1, 0, At, B0); PG8_MMA(1, 1, At, B1); PG8_BAR; PG8_SCHED;
            } else {
            PG8_LDB(B0, 0, 0); PG8_SCHED; PG8_LDA(At, 0, 0); PG8_STAGE(PG8_SA(1, 1), a1 + hstep, voffA);
            PG8_WAIT_L(8); PG8_BAR; PG8_WAIT_L(0); PG8_MMA(0, 0, At, B0); PG8_BAR; PG8_SCHED;
            PG8_LDB(B1, 0, 1); PG8_STAGE(PG8_SB(0, 0), b2, voffB);
            PG8_BAR; PG8_WAIT_L(0); PG8_MMA(0, 1, At, B1); PG8_BAR;
            PG8_LDA(At, 0, 1); PG8_STAGE(PG8_SA(0, 0), a2, voffA);
            PG8_BAR; PG8_WAIT_L(0); PG8_MMA(1, 0, At, B0); PG8_BAR; PG8_SCHED;
            PG8_STAGE(PG8_SB(0, 1), b2 + hstep, voffB);
            PG8_WAIT_V(6); PG8_BAR; PG8_MMA(1, 1, At, B1); PG8_BAR;
            PG8_LDB(B0, 1, 0); PG8_SCHED; PG8_LDA(At, 1, 0); PG8_STAGE(PG8_SA(0, 1), a2 + hstep, voffA);
            PG8_WAIT_L(8); PG8_BAR; PG8_WAIT_L(0); PG8_MMA(0, 0, At, B0); PG8_BAR; PG8_SCHED;
            PG8_LDB(B1, 1, 1); PG8_STAGE(PG8_SB(1, 0), b3, voffB);
            PG8_BAR; PG8_WAIT_L(0); PG8_MMA(0, 1, At, B1); PG8_BAR;
            PG8_LDA(At, 1, 1); PG8_STAGE(PG8_SA(1, 0), a3, voffA);
            PG8_BAR; PG8_WAIT_L(0); PG8_MMA(1, 0, At, B0); PG8_BAR; PG8_SCHED;
            PG8_STAGE(PG8_SB(1, 1), b3 + hstep, voffB);
            PG8_WAIT_V(6); PG8_BAR; PG8_MMA(1, 1, At, B1); PG8_BAR;
            }
        }
        if constexpr (ALIGN_EPI) { if (wr == 0) PG8_BAR; }
        if constexpr (!Epi::AFTER_DRAIN) { E(acc, cur, wr, wc, fr, fq); S.done(cur); }
        if (!has_next) break;
        if (!Epi::keep(cur))
#pragma unroll
        for (int a = 0; a < 2; ++a)
#pragma unroll
            for (int b = 0; b < 2; ++b)
#pragma unroll
                for (int m = 0; m < 4; ++m)
#pragma unroll
                    for (int n = 0; n < 2; ++n) acc[a][b][m][n] = (f32x4){0.f, 0.f, 0.f, 0.f};
        cur = nxt; cA = nA; cB = nB; ++ui;
        if constexpr (ALIGN_EPI) { if (wr == 1) PG8_BAR; }
    }
    PG8_WAIT_V(0);
    if constexpr (!ALIGN_EPI) { if (wr == 0) PG8_BAR; }
    PG8_BAR;
    if constexpr (Epi::AFTER_DRAIN) { E.fused(acc, cur, wr, wc, fr, fq, lds, wid, lane); S.done(cur); }
#undef PG8_SA
#undef PG8_SB
#undef PG8_STAGE
#undef PG8_LDA
#undef PG8_LDB
#undef PG8_MMA
#undef PG8_WAIT_V
#undef PG8_WAIT_L
#undef PG8_BAR
#undef PG8_SCHED
}
}
#define GAS __attribute__((address_space(1)))
#define LAS __attribute__((address_space(3)))
typedef unsigned short bf16;
typedef unsigned v4u __attribute__((ext_vector_type(4)));
typedef unsigned v2u __attribute__((ext_vector_type(2)));
typedef float f32x4 __attribute__((ext_vector_type(4)));
typedef float f32x16 __attribute__((ext_vector_type(16)));
typedef short bf16x8 __attribute__((ext_vector_type(8)));
typedef short s16x4 __attribute__((ext_vector_type(4)));
constexpr int NWAVES = 8, NTHR = 512;
constexpr int RING_BYTES = 131072, LDS_BYTES = 147456;
constexpr size_t MiB = 1u << 20;
constexpr size_t WS_MOD = 1 * MiB, WS_ROPE = 1 * MiB + 512 * 1024, WS_W = 2 * MiB, WL_STRIDE = 27 * MiB + 512 * 1024;
constexpr size_t WO_IN = 0, WO_P = 7 * MiB, WO_O = 9 * MiB, WO_GU = 11 * MiB, WO_D = 22 * MiB;
constexpr size_t WS_X = 112 * MiB, WS_H = 180 * MiB, WS_Q = 214 * MiB, WS_K = 248 * MiB, WS_VT = 256 * MiB + 512 * 1024, WS_SG = 265 * MiB, WS_Y = 333 * MiB, WS_HF = 265 * MiB, WS_END = 367 * MiB;
static_assert(WS_W + DEPTH * WL_STRIDE <= WS_X && WS_X + (size_t)MALL * DM * 4 <= WS_H && WS_H + (size_t)MALL * DM * 2 <= WS_Q && WS_Q + (size_t)2 * NB * 8 * SALL * 64 * 2 <= WS_K, "ws map 1");
static_assert(WS_K + (size_t)2 * NB * 2 * SALL * 64 * 2 <= WS_VT && WS_VT + (size_t)2 * NB * 2 * SALL * 64 * 2 <= WS_SG && WS_SG + (size_t)2 * MALL * DM * 2 <= WS_Y && WS_Y + (size_t)2 * MALL * 512 * 2 <= WS_END && WS_HF + (size_t)MALL * DFF * 2 <= WS_END, "ws map 2");

struct Args { const float* in[19]; float* out; unsigned char* ws; };
struct Frame { LAS unsigned char* lds; int tid, lane, wave, G, bid; };

__device__ __forceinline__ unsigned f2bf(float f) { unsigned u = __builtin_bit_cast(unsigned, f); return (u + 0x7fffu + ((u >> 16) & 1u)) >> 16; }
__device__ __forceinline__ unsigned pk2(float lo, float hi) { return f2bf(lo) | (f2bf(hi) << 16); }
__device__ __forceinline__ float wave_sum(float v) {
#pragma unroll
    for (int o = 1; o < 64; o <<= 1) v += __shfl_xor(v, o);
    return v;
}
__device__ __forceinline__ int wrow_map(int mode, int n) {
    if (mode == 1) return ((n >> 8) << 8) + (((n & 63) >> 5) << 7) + (((n >> 6) & 3) << 5) + (n & 31);
    if (mode == 2) return ((n >> 4) << 5) + (n & 15);
    if (mode == 3) return ((n >> 4) << 5) + 16 + (n & 15);
    return n;
}
__device__ __forceinline__ void transpose_item(const float* W, int K, int N, bf16* WT, int row_off, int mode, LAS float* scr, int item, int lane) {
    const int nblk = N / 32, kb = item / nblk, nb = item % nblk, k0 = 64 * kb, n0 = 32 * nb;
#pragma unroll 8
    for (int i = 0; i < 32; ++i) { const int kk = 2 * i + (lane >> 5); scr[kk * 33 + (lane & 31)] = W[(size_t)(k0 + kk) * N + n0 + (lane & 31)]; }
    asm volatile("s_waitcnt lgkmcnt(0)" ::: "memory");
    const int c = lane & 7;
#pragma unroll
    for (int j = 0; j < 4; ++j) { const int n = (lane >> 3) + 8 * j; const LAS float* s = scr + (8 * c) * 33 + n;
        v4u o; o.x = pk2(s[0 * 33], s[1 * 33]); o.y = pk2(s[2 * 33], s[3 * 33]); o.z = pk2(s[4 * 33], s[5 * 33]); o.w = pk2(s[6 * 33], s[7 * 33]);
        *(v4u*)(WT + (size_t)(row_off + wrow_map(mode, n0 + n)) * K + k0 + 8 * c) = o; }
    asm volatile("s_waitcnt lgkmcnt(0)" ::: "memory");
}
__device__ __forceinline__ void prologue(const Frame& F, const Args& a) {
    unsigned char* ws = a.ws;
    LAS float* sv = (LAS float*)F.lds; LAS float* part = (LAS float*)(F.lds + 20480);
    for (int i = F.tid; i < 5 * 1024; i += NTHR) { const int v = i >> 10, k = i & 1023; const float cv = v < 4 ? a.in[1][v * 1024 + k] : a.in[3][k]; sv[i] = cv / (1.0f + expf(-cv)); }
    __syncthreads();
    float* mod = (float*)(ws + WS_MOD);
    for (int item = F.bid; item < DEPTH * 96; item += F.G) {
        const int l = item / 96, n0 = (item % 96) * 64, k0 = F.wave * 128;
        const float* W = a.in[4] + (size_t)l * 1024 * 6144 + (size_t)k0 * 6144 + n0 + F.lane;
        float a0 = 0.f, a1 = 0.f, a2 = 0.f, a3 = 0.f, a4 = 0.f;
#pragma unroll 8
        for (int kk = 0; kk < 128; ++kk) { const float w = W[(size_t)kk * 6144]; const int k = k0 + kk;
            a0 += sv[k] * w; a1 += sv[1024 + k] * w; a2 += sv[2048 + k] * w; a3 += sv[3072 + k] * w; a4 += sv[4096 + k] * w; }
        part[(F.wave * 5 + 0) * 64 + F.lane] = a0; part[(F.wave * 5 + 1) * 64 + F.lane] = a1; part[(F.wave * 5 + 2) * 64 + F.lane] = a2;
        part[(F.wave * 5 + 3) * 64 + F.lane] = a3; part[(F.wave * 5 + 4) * 64 + F.lane] = a4;
        __syncthreads();
        if (F.tid < 320) { const int v = F.tid >> 6, ln = F.tid & 63; float s = a.in[5][l * 6144 + n0 + ln];
#pragma unroll
            for (int w = 0; w < 8; ++w) s += part[(w * 5 + v) * 64 + ln];
            mod[(size_t)(l * 5 + v) * 6144 + n0 + ln] = s; }
        __syncthreads();
    }
    if (F.bid == F.G - 1) { float* rc = (float*)(ws + WS_ROPE); float* rs = rc + 1024;
        for (int i = F.tid; i < 1024; i += NTHR) { const int pos = i >> 4, j = i & 15; const float inv = powf(10000.0f, -(float)j / 16.0f); const float ang = (float)pos * inv; rc[i] = cosf(ang); rs[i] = sinf(ang); } }
    __syncthreads();
    LAS float* scr = (LAS float*)(F.lds + F.wave * 16384);
    const int gw = F.bid * NWAVES + F.wave, NGW = F.G * NWAVES;
    constexpr int I_IN = 16 * 112, I_P = 8 * 32, I_O = 16 * 32, I_G = 16 * 88, I_D = 44 * 32, I_L = I_IN + 2 * I_P + I_O + 2 * I_G + I_D;
    for (int it = gw; it < DEPTH * I_L; it += NGW) {
        const int l = it / I_L; int r = it % I_L; unsigned char* wl = ws + WS_W + (size_t)l * WL_STRIDE;
        if (r < I_IN) { transpose_item(a.in[8] + (size_t)l * 1024 * INC, 1024, INC, (bf16*)(wl + WO_IN), 0, 1, scr, r, F.lane); continue; } r -= I_IN;
        if (r < I_P) { transpose_item(a.in[12] + (size_t)l * 512 * 1024, 512, 1024, (bf16*)(wl + WO_P), 0, 0, scr, r, F.lane); continue; } r -= I_P;
        if (r < I_P) { transpose_item(a.in[13] + (size_t)l * 512 * 1024, 512, 1024, (bf16*)(wl + WO_P), 1024, 0, scr, r, F.lane); continue; } r -= I_P;
        if (r < I_O) { transpose_item(a.in[14] + (size_t)l * 1024 * 1024, 1024, 1024, (bf16*)(wl + WO_O), 0, 0, scr, r, F.lane); continue; } r -= I_O;
        if (r < I_G) { transpose_item(a.in[15] + (size_t)l * 1024 * DFF, 1024, DFF, (bf16*)(wl + WO_GU), 0, 2, scr, r, F.lane); continue; } r -= I_G;
        if (r < I_G) { transpose_item(a.in[16] + (size_t)l * 1024 * DFF, 1024, DFF, (bf16*)(wl + WO_GU), 0, 3, scr, r, F.lane); continue; } r -= I_G;
        transpose_item(a.in[17] + (size_t)l * DFF * 1024, DFF, 1024, (bf16*)(wl + WO_D), 0, 0, scr, r, F.lane);
    }
}
__device__ __forceinline__ void norm_phase(const Frame& F, const float* xl, const float* xc, float* Xcopy, bf16* H, const float* g, const float* modl, int shidx, int M) {
    const int gw = F.bid * NWAVES + F.wave, NGW = F.G * NWAVES;
    f32x4 gv[4];
#pragma unroll
    for (int j = 0; j < 4; ++j) gv[j] = *(const f32x4*)(g + 4 * F.lane + 256 * j);
    for (int row = gw; row < M; row += NGW) {
        const int v = row < MLAT ? row >> 12 : 4;
        const float* xr = row < MLAT ? xl + (size_t)row * DM : xc + (size_t)(row - MLAT) * DM;
        f32x4 x[4]; float ss = 0.f;
#pragma unroll
        for (int j = 0; j < 4; ++j) { x[j] = *(const f32x4*)(xr + 4 * F.lane + 256 * j); ss += (x[j][0] * x[j][0] + x[j][1] * x[j][1]) + (x[j][2] * x[j][2] + x[j][3] * x[j][3]); }
        const float rstd = 1.0f / sqrtf(wave_sum(ss) * (1.0f / DM) + NORM_EPS);
        const float* mv = modl + v * 6144 + shidx * 1024;
#pragma unroll
        for (int j = 0; j < 4; ++j) { const int col = 4 * F.lane + 256 * j; const f32x4 sh = *(const f32x4*)(mv + col), sc = *(const f32x4*)(mv + 1024 + col);
            const f32x4 h = ((x[j] * rstd) * gv[j]) * (sc + 1.0f) + sh;
            v2u w; w.x = pk2(h[0], h[1]); w.y = pk2(h[2], h[3]); *(v2u*)(H + (size_t)row * DM + col) = w;
            if (Xcopy) *(f32x4*)(Xcopy + (size_t)row * DM + col) = x[j]; }
    }
}
__device__ __forceinline__ void final_norm(const Frame& F, const float* X, float* out, const float* g) {
    const int gw = F.bid * NWAVES + F.wave, NGW = F.G * NWAVES;
    f32x4 gv[4];
#pragma unroll
    for (int j = 0; j < 4; ++j) gv[j] = *(const f32x4*)(g + 4 * F.lane + 256 * j);
    for (int row = gw; row < MLAT; row += NGW) {
        const float* xr = X + (size_t)row * DM; f32x4 x[4]; float ss = 0.f;
#pragma unroll
        for (int j = 0; j < 4; ++j) { x[j] = *(const f32x4*)(xr + 4 * F.lane + 256 * j); ss += (x[j][0] * x[j][0] + x[j][1] * x[j][1]) + (x[j][2] * x[j][2] + x[j][3] * x[j][3]); }
        const float rstd = 1.0f / sqrtf(wave_sum(ss) * (1.0f / DM) + NORM_EPS);
#pragma unroll
        for (int j = 0; j < 4; ++j) *(f32x4*)(out + (size_t)row * DM + 4 * F.lane + 256 * j) = (x[j] * rstd) * gv[j];
    }
}
constexpr int AK_PITCH = 144, AV_PITCH = 144, AK_BYTES = 64 * AK_PITCH, AV_BYTES = 64 * AV_PITCH, AV_OFF = 2 * AK_BYTES;
typedef float f32x2_t __attribute__((ext_vector_type(2))); typedef __bf16 bf16x2_t __attribute__((ext_vector_type(2)));
__device__ __forceinline__ unsigned cvtpk(float lo, float hi) { f32x2_t v = {lo, hi}; bf16x2_t b = __builtin_convertvector(v, bf16x2_t); return __builtin_bit_cast(unsigned, b); }
#define MX3(a, b, c) __builtin_fmaxf(__builtin_fmaxf((a), (b)), (c))
constexpr float ATT_THR = 8.0f;
__device__ __forceinline__ void attn_unit(const Frame& F, const bf16* Qb, const bf16* Kb, const bf16* VTb, bf16* Yb, int kvh, int qs, int yrow0, int ta, int tb, bool wmask, bool has_sink, const float* sink) {
    const int tid = F.tid, lane = F.lane, r32 = lane & 31, hi = lane >> 5, wave = F.wave;
    const int head = kvh * 4 + (wave >> 1), qrow = qs + 32 * (wave & 1) + r32;
    const bf16* qp = Qb + ((size_t)head * SALL + qrow) * 64 + hi * 8;
    bf16x8 qr[4];
#pragma unroll
    for (int d0 = 0; d0 < 4; ++d0) qr[d0] = *(const bf16x8*)(qp + 16 * d0);
    const int nl = tb - ta, nt = nl + 4, qt = qs >> 6;
    const int srow = tid >> 3, sch = tid & 7;
    const bf16* kg = Kb + (size_t)srow * 64 + sch * 8;
    const bf16* vg = VTb + (size_t)srow * SALL + sch * 8;
    LAS unsigned char* kw = F.lds + srow * AK_PITCH + sch * 16;
    LAS unsigned char* vw = F.lds + AV_OFF + srow * AV_PITCH + (sch >> 1) * 32 + (sch & 1) * 8;
#define ATT_TILE(i) ((i) < nl ? ta + (i) : 64 + (i) - nl)
    v4u kr[2], vr[2];
    { const int t = ATT_TILE(0), t1 = ATT_TILE(1); kr[0] = *(const v4u*)(kg + (size_t)t * 4096); vr[0] = *(const v4u*)(vg + t * 64); kr[1] = *(const v4u*)(kg + (size_t)t1 * 4096); vr[1] = *(const v4u*)(vg + t1 * 64); }
    *(LAS v4u*)kw = kr[0]; *(LAS v2u*)vw = (v2u){vr[0].x, vr[0].y}; *(LAS v2u*)(vw + 16) = (v2u){vr[0].z, vr[0].w};
    const float sink2 = has_sink ? sink[head] * LOG2E : 0.0f;
    float mref = sink2, lrun = 0.f;
    f32x16 o0, o1, negm;
#pragma unroll
    for (int r = 0; r < 16; ++r) { o0[r] = 0.f; o1[r] = 0.f; negm[r] = -mref; }
    __syncthreads();
    for (int ii = 0; ii < nt; ii += 2) {
#pragma unroll
      for (int h = 0; h < 2; ++h) { const int i = ii + h; if (i < nt) {
        const int cur = i & 1, t = ATT_TILE(i);
        const bool more = i + 1 < nt;
        if (i + 2 < nt) { const int t2 = ATT_TILE(i + 2); kr[h] = *(const v4u*)(kg + (size_t)t2 * 4096); vr[h] = *(const v4u*)(vg + t2 * 64); }
        f32x16 s0 = negm, s1 = negm;
        const LAS unsigned char* kb = F.lds + cur * AK_BYTES + r32 * AK_PITCH + hi * 16;
        const LAS unsigned char* vb = F.lds + AV_OFF + cur * AV_BYTES + r32 * AV_PITCH + hi * 16;
        bf16x8 kf0[4], kf1[4];
#pragma unroll
        for (int d0 = 0; d0 < 4; ++d0) { kf0[d0] = *(const LAS bf16x8*)(kb + d0 * 32); kf1[d0] = *(const LAS bf16x8*)(kb + 32 * AK_PITCH + d0 * 32); }
        __builtin_amdgcn_sched_barrier(0);
#pragma unroll
        for (int d0 = 0; d0 < 4; ++d0) { s0 = __builtin_amdgcn_mfma_f32_32x32x16_bf16(kf0[d0], qr[d0], s0, 0, 0, 0); s1 = __builtin_amdgcn_mfma_f32_32x32x16_bf16(kf1[d0], qr[d0], s1, 0, 0, 0); }
        __builtin_amdgcn_sched_barrier(0);
        bf16x8 vfa[4], vfb[4];
#pragma unroll
        for (int c = 0; c < 4; ++c) { vfa[c] = *(const LAS bf16x8*)(vb + c * 32); vfb[c] = *(const LAS bf16x8*)(vb + 32 * AV_PITCH + c * 32); }
        __builtin_amdgcn_sched_barrier(0);
        if (wmask && t < 64 && (t == qt - 2 || t == qt + 2)) {
            const int kb0 = t * 64 + 4 * hi - qrow;
#pragma unroll
            for (int r = 0; r < 16; ++r) { const int rel = kb0 + (r & 3) + 8 * (r >> 2); if (rel > 128 || rel < -128) s0[r] = -1e30f; if (rel + 32 > 128 || rel + 32 < -128) s1[r] = -1e30f; }
        }
        float ma = MX3(s0[0], s0[1], s1[0]), mb = MX3(s0[2], s0[3], s1[1]); ma = MX3(ma, s1[2], s1[3]);
#pragma unroll
        for (int r = 4; r < 16; r += 4) { ma = MX3(ma, s0[r], s0[r + 1]); mb = MX3(mb, s0[r + 2], s0[r + 3]); ma = MX3(ma, s1[r], s1[r + 1]); mb = MX3(mb, s1[r + 2], s1[r + 3]); }
        float rm = __builtin_fmaxf(ma, mb); rm = __builtin_fmaxf(rm, __shfl_xor(rm, 32));
        const bool first = (i == 0) && !has_sink;
        if (first || __any(rm > ATT_THR)) {
            const float dl = first ? rm : __builtin_fmaxf(rm, 0.f);
            mref += dl;
#pragma unroll
            for (int r = 0; r < 16; ++r) { s0[r] -= dl; s1[r] -= dl; negm[r] = -mref; }
            if (!first) { const float f = __builtin_amdgcn_exp2f(-dl); lrun *= f;
#pragma unroll
                for (int r = 0; r < 16; ++r) { o0[r] *= f; o1[r] *= f; } }
        }
        f32x2_t ls2 = {0.f, 0.f};
#pragma unroll
        for (int r = 0; r < 16; r += 2) { s0[r] = __builtin_amdgcn_exp2f(s0[r]); s0[r + 1] = __builtin_amdgcn_exp2f(s0[r + 1]); s1[r] = __builtin_amdgcn_exp2f(s1[r]); s1[r + 1] = __builtin_amdgcn_exp2f(s1[r + 1]);
            ls2 += (f32x2_t){s0[r], s0[r + 1]}; ls2 += (f32x2_t){s1[r], s1[r + 1]}; }
        lrun += ls2.x + ls2.y;
        bf16x8 pf[4];
#pragma unroll
        for (int c = 0; c < 2; ++c) { v4u w0, w1;
            w0.x = cvtpk(s0[8 * c + 0], s0[8 * c + 1]); w0.y = cvtpk(s0[8 * c + 2], s0[8 * c + 3]); w0.z = cvtpk(s0[8 * c + 4], s0[8 * c + 5]); w0.w = cvtpk(s0[8 * c + 6], s0[8 * c + 7]);
            w1.x = cvtpk(s1[8 * c + 0], s1[8 * c + 1]); w1.y = cvtpk(s1[8 * c + 2], s1[8 * c + 3]); w1.z = cvtpk(s1[8 * c + 4], s1[8 * c + 5]); w1.w = cvtpk(s1[8 * c + 6], s1[8 * c + 7]);
            pf[c] = __builtin_bit_cast(bf16x8, w0); pf[2 + c] = __builtin_bit_cast(bf16x8, w1); }
#pragma unroll
        for (int c = 0; c < 4; ++c) {
            o0 = __builtin_amdgcn_mfma_f32_32x32x16_bf16(vfa[c], pf[c], o0, 0, 0, 0); o1 = __builtin_amdgcn_mfma_f32_32x32x16_bf16(vfb[c], pf[c], o1, 0, 0, 0);
        }
        if (more) { const int nb = cur ^ 1; *(LAS v4u*)(kw + nb * AK_BYTES) = kr[h ^ 1]; *(LAS v2u*)(vw + nb * AV_BYTES) = (v2u){vr[h ^ 1].x, vr[h ^ 1].y}; *(LAS v2u*)(vw + nb * AV_BYTES + 16) = (v2u){vr[h ^ 1].z, vr[h ^ 1].w}; }
        __syncthreads();
      } }
    }
#undef ATT_TILE
    lrun += __shfl_xor(lrun, 32);
    if (has_sink) lrun += __builtin_amdgcn_exp2f(sink2 - mref);
    const float inv = 1.0f / lrun;
    bf16* yp = Yb + (size_t)(yrow0 + 32 * (wave & 1) + r32) * 512 + head * 64 + 4 * hi;
#pragma unroll
    for (int r4 = 0; r4 < 4; ++r4) { v2u w; w.x = cvtpk(o0[4 * r4] * inv, o0[4 * r4 + 1] * inv); w.y = cvtpk(o0[4 * r4 + 2] * inv, o0[4 * r4 + 3] * inv); *(v2u*)(yp + 8 * r4) = w;
        w.x = cvtpk(o1[4 * r4] * inv, o1[4 * r4 + 1] * inv); w.y = cvtpk(o1[4 * r4 + 2] * inv, o1[4 * r4 + 3] * inv); *(v2u*)(yp + 32 + 8 * r4) = w; }
}
__device__ __forceinline__ void attn_phase(const Frame& F, const bf16* Q, const bf16* K, const bf16* VT, bf16* Y, const float* sink, int nunits) {
    for (int U = F.bid; U < nunits; U += F.G) {
        int br, grp, qblk; bool isctx = false;
        if (U < 512) { br = 1; grp = U & 7; qblk = U >> 3; }
        else if (U < 1024) { br = 0; grp = U & 7; qblk = (U - 512) >> 3; }
        else { const int u2 = U - 1024; isctx = true; br = u2 >> 5; grp = (u2 >> 2) & 7; qblk = u2 & 3; }
        const int b = grp >> 1, kvh = grp & 1;
        const bf16* Qb = Q + (size_t)(br * NB + b) * 8 * SALL * 64;
        const bf16* Kb = K + (size_t)((br * NB + b) * 2 + kvh) * SALL * 64;
        const bf16* VTb = VT + (size_t)((br * NB + b) * 2 + kvh) * 64 * SALL;
        bf16* Yb = Y + (size_t)br * MALL * 512;
        int ta = 0, tb = 0; bool wmask = false;
        if (!isctx) { if (br == 1) { ta = 0; tb = 64; } else { ta = qblk - 2 < 0 ? 0 : qblk - 2; tb = qblk + 3 > 64 ? 64 : qblk + 3; wmask = true; } }
        const int qs = isctx ? SEQ + 64 * qblk : 64 * qblk;
        const int yrow0 = isctx ? MLAT + b * CTXL + 64 * qblk : b * SEQ + 64 * qblk;
        attn_unit(F, Qb, Kb, VTb, Yb, kvh, qs, yrow0, ta, tb, wmask, br == 0, sink);
    }
}
typedef GAS unsigned gu32;
typedef GAS unsigned long long gu64;
#define RLX_AGENT __ATOMIC_RELAXED, __HIP_MEMORY_SCOPE_AGENT
#define XB_TMO      128
#define XB_XCNT(j)  (256  + 64 * (j))
#define XB_XSUB(j)  (1280 + 64 * (j))
#define XB_XGEN(j)  (2304 + 64 * (j))
#define XB_TOP      3328
#define XB_TOPGEN   3392
#define XCD_BAR_WORDS 3456
#define XB_SPIN_CAP (1u << 18)

__device__ __forceinline__ unsigned xb_ld(unsigned* p)              { return __hip_atomic_load(p, __ATOMIC_RELAXED, __HIP_MEMORY_SCOPE_AGENT); }
__device__ __forceinline__ unsigned xb_add(unsigned* p, unsigned v) { return __hip_atomic_fetch_add(p, v, __ATOMIC_RELAXED, __HIP_MEMORY_SCOPE_AGENT); }
__device__ __forceinline__ unsigned xb_xcc_id() { return (unsigned)__builtin_amdgcn_s_getreg((3 << 11) | 20) & 0xFu; }
#define XB_SPIN(cond, bar) do { unsigned _sp = 0; while (cond) { __builtin_amdgcn_s_sleep(1); \
    if ((++_sp & 255u) == 0u) { if (xb_ld(&(bar)[XB_TMO])) break; if (_sp > XB_SPIN_CAP) { atomicAdd(&(bar)[XB_TMO], 1u); break; } } } } while (0)

struct XcdBarrier {
    unsigned* bar; unsigned x;
    volatile LAS unsigned* st;
};

__device__ __forceinline__ XcdBarrier xcd_barrier_post(unsigned* bar, volatile LAS unsigned* st) {
    XcdBarrier b; b.bar = bar; b.x = xb_xcc_id(); b.st = st;
    if (threadIdx.x == 0) (void)xb_add(&bar[XB_XCNT(b.x)], 1u);
    return b;
}
__device__ __forceinline__ void xcd_barrier_complete(unsigned* bar, unsigned x, unsigned& nloc, unsigned& nx) {
    const unsigned G = gridDim.x * gridDim.y * gridDim.z;
    unsigned sum, cnt, mine, sp = 0u;
    for (;;) {
        sum = 0u; cnt = 0u; mine = 0u;
#pragma unroll
        for (unsigned j = 0; j < 16; ++j) { const unsigned c = xb_ld(&bar[XB_XCNT(j)]); sum += c; cnt += (c > 0u) ? 1u : 0u; mine = (j == x) ? c : mine; }
        if (sum == G) break;
        __builtin_amdgcn_s_sleep(1);
        if ((++sp & 255u) == 0u) { if (xb_ld(&bar[XB_TMO])) break; if (sp > XB_SPIN_CAP) { atomicAdd(&bar[XB_TMO], 1u); break; } }
    }
    nloc = mine > 0u ? mine : 1u; nx = cnt > 0u ? cnt : 1u;
}

__device__ __forceinline__ void xcd_barrier(const XcdBarrier& b) {
    asm volatile("s_waitcnt vmcnt(0)" ::: "memory");
    __syncthreads();
    if (threadIdx.x == 0) {
        unsigned* bar = b.bar;
        __builtin_amdgcn_s_waitcnt(0);
        unsigned nloc = b.st[0], nx = b.st[1];
        if (nloc == 0u) { xcd_barrier_complete(bar, b.x, nloc, nx); b.st[0] = nloc; b.st[1] = nx; }
        const unsigned old = xb_add(&bar[XB_XSUB(b.x)], 1u);
        const unsigned gen = old / nloc;
        if (old + 1u == (gen + 1u) * nloc) {
            __builtin_amdgcn_fence(__ATOMIC_RELEASE, "agent");
            asm volatile("s_waitcnt vmcnt(0)" ::: "memory");
            const unsigned og = xb_add(&bar[XB_TOP], 1u);
            const unsigned tg = og / nx;
            if (og + 1u == (tg + 1u) * nx) xb_add(&bar[XB_TOPGEN], 1u);
            else XB_SPIN(xb_ld(&bar[XB_TOPGEN]) == tg, bar);
            __builtin_amdgcn_fence(__ATOMIC_ACQUIRE, "agent");
            xb_add(&bar[XB_XGEN(b.x)], 1u);
            asm volatile("s_waitcnt vmcnt(0)" ::: "memory");
        } else {
            XB_SPIN(xb_ld(&bar[XB_XGEN(b.x)]) == gen, bar);
            __builtin_amdgcn_fence(__ATOMIC_ACQUIRE, "agent");
            asm volatile("s_waitcnt vmcnt(0)" ::: "memory");
        }
    }
    __syncthreads();
}

__device__ __forceinline__ void mini_block(const bf16* A, int lda, const bf16* Bt, int ldb, int K, f32x4& c0, f32x4& c1, int lane) {
    const int fr = lane & 15, fq = lane >> 4;
    const bf16* ap = A + (size_t)fr * lda + 8 * fq;
    const bf16* b0p = Bt + (size_t)fr * ldb + 8 * fq; const bf16* b1p = b0p + (size_t)16 * ldb;
    bf16x8 a0[4], p0[4], q0[4], a1[4], p1[4], q1[4];
#define MINI_LD(a, p, q, kk) do { _Pragma("unroll") for (int u = 0; u < 4; ++u) { a[u] = *(const bf16x8*)(ap + (kk) + 32 * u); p[u] = *(const bf16x8*)(b0p + (kk) + 32 * u); q[u] = *(const bf16x8*)(b1p + (kk) + 32 * u); } } while (0)
#define MINI_MM(a, p, q) do { _Pragma("unroll") for (int u = 0; u < 4; ++u) { c0 = __builtin_amdgcn_mfma_f32_16x16x32_bf16(p[u], a[u], c0, 0, 0, 0); c1 = __builtin_amdgcn_mfma_f32_16x16x32_bf16(q[u], a[u], c1, 0, 0, 0); } } while (0)
    MINI_LD(a0, p0, q0, 0);
    for (int k = 0; k < K; k += 256) {
        MINI_LD(a1, p1, q1, k + 128);
        MINI_MM(a0, p0, q0);
        if (k + 256 < K) MINI_LD(a0, p0, q0, k + 256);
        MINI_MM(a1, p1, q1);
    }
#undef MINI_LD
#undef MINI_MM
}
__device__ __forceinline__ unsigned long long pack4u(f32x4 v) { return (unsigned long long)pk2(v[0], v[1]) | ((unsigned long long)pk2(v[2], v[3]) << 32); }
__device__ __forceinline__ f32x4 unpack4u(v2u w) { f32x4 v; v[0] = __uint_as_float(w.x << 16); v[1] = __uint_as_float(w.x & 0xffff0000u); v[2] = __uint_as_float(w.y << 16); v[3] = __uint_as_float(w.y & 0xffff0000u); return v; }
__device__ __forceinline__ void ctx_merge_tiles(const Frame& F, const bf16* Y, const bf16* Wp, const bf16* SG, bf16* Mb) {
    const int fr = F.lane & 15, fq = F.lane >> 4, wi = F.wave >> 1, wj = F.wave & 1;
    for (int t = F.bid; t < 256; t += F.G) {
        const int row0 = MLAT + 64 * (t >> 4) + 16 * wi, col0 = 64 * (t & 15) + 32 * wj;
        f32x4 a0 = {0.f, 0.f, 0.f, 0.f}, a1 = a0, b0 = a0, b1 = a0;
        mini_block(Y + (size_t)row0 * 512, 512, Wp + (size_t)col0 * 512, 512, 512, a0, a1, F.lane);
        mini_block(Y + ((size_t)MALL + row0) * 512, 512, Wp + (size_t)(1024 + col0) * 512, 512, 512, b0, b1, F.lane);
        const size_t off = (size_t)(row0 + fr) * 1024 + col0 + 4 * fq;
        const f32x4 sa0 = unpack4u(*(const v2u*)(SG + off)), sa1 = unpack4u(*(const v2u*)(SG + off + 16));
        const f32x4 sb0 = unpack4u(*(const v2u*)(SG + (size_t)MALL * 1024 + off)), sb1 = unpack4u(*(const v2u*)(SG + (size_t)MALL * 1024 + off + 16));
        *(unsigned long long*)(Mb + off) = pack4u(sa0 * a0 + sb0 * b0); *(unsigned long long*)(Mb + off + 16) = pack4u(sa1 * a1 + sb1 * b1);
    }
}
__device__ __forceinline__ void ctx_resid_tiles(const Frame& F, const bf16* A, int K, const bf16* Bt, const float* gate_ctx, float* X) {
    const int fr = F.lane & 15, fq = F.lane >> 4, wi = F.wave >> 1, wj = F.wave & 1;
    for (int t = F.bid; t < 256; t += F.G) {
        const int row0 = MLAT + 64 * (t >> 4) + 16 * wi, col0 = 64 * (t & 15) + 32 * wj;
        f32x4 c0 = {0.f, 0.f, 0.f, 0.f}, c1 = c0;
        float* xp = X + (size_t)(row0 + fr) * 1024 + col0 + 4 * fq;
        const f32x4 x0 = *(const f32x4*)xp, x1 = *(const f32x4*)(xp + 16);
        const f32x4 g0 = *(const f32x4*)(gate_ctx + col0 + 4 * fq), g1 = *(const f32x4*)(gate_ctx + col0 + 4 * fq + 16);
        mini_block(A + (size_t)row0 * K, K, Bt + (size_t)col0 * K, K, K, c0, c1, F.lane);
        *(f32x4*)xp = x0 + g0 * c0; *(f32x4*)(xp + 16) = x1 + g1 * c1;
    }
}
__global__ void __launch_bounds__(NTHR, 2) fwd_megakernel(Args args) {
    extern __shared__ __attribute__((aligned(16))) unsigned char lds_raw[];
    cg::grid_group grid = cg::this_grid();
    Frame F;
#define MKFRAME() do { int t_ = threadIdx.x; asm volatile("" : "+v"(t_)); F.lds = (LAS unsigned char*)lds_raw; F.tid = t_; F.lane = t_ & 63; F.wave = __builtin_amdgcn_readfirstlane(t_ >> 6); F.G = gridDim.x; F.bid = blockIdx.x; } while (0)
    MKFRAME();
    unsigned char* ws = args.ws;
    float* X = (float*)(ws + WS_X); bf16* H = (bf16*)(ws + WS_H); bf16* Qb = (bf16*)(ws + WS_Q); bf16* Kb = (bf16*)(ws + WS_K); bf16* VTb = (bf16*)(ws + WS_VT);
    bf16* SG = (bf16*)(ws + WS_SG); bf16* Y = (bf16*)(ws + WS_Y); bf16* HF = (bf16*)(ws + WS_HF);
    const float* mod = (const float*)(ws + WS_MOD); const float* rc = (const float*)(ws + WS_ROPE); const float* rs = rc + 1024;
    volatile LAS unsigned* MISC = (volatile LAS unsigned*)((LAS unsigned char*)lds_raw + RING_BYTES + 320);
    if (threadIdx.x < 32) MISC[threadIdx.x] = 0u;
    __syncthreads();
    XcdBarrier bar = xcd_barrier_post((unsigned*)(ws + 4096 * 4), MISC + 8);
    prologue(F, args);
    grid.sync();
    LAS float* ropel = (LAS float*)((LAS unsigned char*)lds_raw + RING_BYTES + 1024);
    for (int i = threadIdx.x; i < 2048; i += NTHR) ropel[i] = rc[i];
    __syncthreads();
    for (int l = 0; l < DEPTH; ++l) {
        const bool last = l == DEPTH - 1;
        const int Mpost = last ? MLAT : MALL;
        const float* modl = mod + (size_t)l * 5 * 6144;
        const unsigned char* wl = ws + WS_W + (size_t)l * WL_STRIDE;
        MKFRAME();
        if (l == 0) norm_phase(F, args.in[0], args.in[2], X, H, args.in[6], modl, 0, MALL);
        else norm_phase(F, X, X + (size_t)MLAT * DM, nullptr, H, args.in[6] + l * DM, modl, 0, MALL);
        xcd_barrier(bar);
        { pg8::Gemm g{H, (const bf16*)(wl + WO_IN), MALL, INC, DM}; pg8::StaticOrder S; S.init(MALL, INC, F.G, F.bid);
          pg8::EpiInProj E{Qb, Kb, VTb, SG, args.in[9] + l * 64, args.in[10] + l * 64, ropel, nullptr, nullptr};
          pg8::gemm_phase<pg8::EpiInProj, pg8::StaticOrder, true, true>(F.lds, g, S, E); }
        xcd_barrier(bar);
        MKFRAME();
        attn_phase(F, Qb, Kb, VTb, Y, args.in[11] + l * 8, last ? 1024 : 1088);
        xcd_barrier(bar);
        { pg8::Gemm g{Y, (const bf16*)(wl + WO_P), MLAT, DM, 512}; pg8::PairedOrder S; S.base.init(MLAT, DM, F.G, F.bid); S.dM = NPAN_ALL; S.dN = 4;
          pg8::EpiMerge E{SG, H};
          pg8::gemm_phase<pg8::EpiMerge, pg8::PairedOrder, true, true>(F.lds, g, S, E); }
        if (!last) { MKFRAME(); ctx_merge_tiles(F, Y, (const bf16*)(wl + WO_P), SG, H); }
        xcd_barrier(bar);
        { pg8::Gemm g{H, (const bf16*)(wl + WO_O), MLAT, DM, DM}; pg8::StaticOrder S; S.init(MLAT, DM, F.G, F.bid);
          pg8::EpiResid E{modl + 2 * 1024, X, nullptr, nullptr, nullptr, nullptr};
          pg8::gemm_phase<pg8::EpiResid, pg8::StaticOrder, true, true>(F.lds, g, S, E); }
        if (!last) { MKFRAME(); ctx_resid_tiles(F, H, DM, (const bf16*)(wl + WO_O), modl + 4 * 6144 + 2 * 1024, X); }
        xcd_barrier(bar);
        MKFRAME();
        norm_phase(F, X, X + (size_t)MLAT * DM, nullptr, H, args.in[7] + l * DM, modl, 3, Mpost);
        xcd_barrier(bar);
        { pg8::Gemm g{H, (const bf16*)(wl + WO_GU), Mpost, NGU, DM}; pg8::StaticOrder S; S.init(Mpost, NGU, F.G, F.bid);
          pg8::EpiSwiGLU E{HF};
          pg8::gemm_phase<pg8::EpiSwiGLU, pg8::StaticOrder, true, true>(F.lds, g, S, E); }
        xcd_barrier(bar);
        { pg8::Gemm g{HF, (const bf16*)(wl + WO_D), MLAT, DM, DFF}; pg8::StaticOrder S; S.init(MLAT, DM, F.G, F.bid);
          pg8::EpiResid E{modl + 5 * 1024, X, nullptr, nullptr, nullptr, nullptr};
          pg8::gemm_phase<pg8::EpiResid, pg8::StaticOrder, true, true>(F.lds, g, S, E); }
        if (!last) { MKFRAME(); ctx_resid_tiles(F, HF, DFF, (const bf16*)(wl + WO_D), modl + 4 * 6144 + 5 * 1024, X); }
        xcd_barrier(bar);
    }
    MKFRAME();
    final_norm(F, X, args.out, args.in[18]);
}

extern "C" void kernel_launch(void* const* d_in, const int* in_sizes, int n_in, void* d_out, int out_size, void* d_ws, size_t ws_size, hipStream_t stream) {
    static int grid = 0;
    if (grid == 0) {
        if (n_in != 19 || ws_size < WS_END) { fprintf(stderr, "kernel_launch: need 19 inputs and >= %zu bytes of workspace (got %d, %zu)\n", (size_t)WS_END, n_in, ws_size); grid = -1; return; }
        int dev = 0, cus = 0, per_cu = 0;
        hipGetDevice(&dev); hipDeviceGetAttribute(&cus, hipDeviceAttributeMultiprocessorCount, dev);
        hipFuncSetAttribute((const void*)fwd_megakernel, hipFuncAttributeMaxDynamicSharedMemorySize, LDS_BYTES);
        if (hipOccupancyMaxActiveBlocksPerMultiprocessor(&per_cu, (const void*)fwd_megakernel, NTHR, LDS_BYTES) != hipSuccess || per_cu < 1) { fprintf(stderr, "kernel_launch: occupancy query says %d\n", per_cu); per_cu = 1; }
        (void)hipGetLastError();
        grid = cus * per_cu;
    }
    if (grid < 0) return;
    if (hipMemsetAsync(d_ws, 0, 65536, stream) != hipSuccess) { fprintf(stderr, "kernel_launch: memset of the barrier words failed\n"); return; }
    Args a{};
    for (int i = 0; i < 19; ++i) a.in[i] = (const float*)d_in[i];
    a.out = (float*)d_out; a.ws = (unsigned char*)d_ws;
    void* kargs[] = {&a};
    hipError_t e = hipLaunchCooperativeKernel((const void*)fwd_megakernel, dim3(grid), dim3(NTHR), kargs, LDS_BYTES, stream);
    if (e != hipSuccess) fprintf(stderr, "cooperative launch failed: %s (grid %d)\n", hipGetErrorString(e), grid);
}
```
